# Optimizing an MI355X kernel written in HIP

```python
import math
import jax, jax.numpy as jnp
from jax import lax
import numpy as np


D_MODEL = 1024
BATCH = 8
SEQ = 2048
DEPTH = 2

HEAD_DIM = 64
DIL_CONFIGS = ((128, 1), (512, 4), (2048, 16))
N_DIL_GROUPS = len(DIL_CONFIGS)
HEADS_PER_GROUP = 4
N_DIL_HEADS = N_DIL_GROUPS * HEADS_PER_GROUP
N_DIFF_HEADS = 4
DIFF_V_DIM = 2 * HEAD_DIM
N_ALIBI_HEADS = N_DIL_HEADS + N_DIFF_HEADS
D_FF = ((8 * D_MODEL // 3 + 127) // 128) * 128
BLOCK = 128
EPS = 1e-6

DIL_WIDTH = N_DIL_HEADS * HEAD_DIM
DIL_OUT = HEADS_PER_GROUP * HEAD_DIM
DIFF_QK_WIDTH = N_DIFF_HEADS * 2 * HEAD_DIM
DIFF_V_WIDTH = N_DIFF_HEADS * DIFF_V_DIM
IN_WIDTHS = (DIL_WIDTH, DIL_WIDTH, DIL_WIDTH, DIFF_QK_WIDTH, DIFF_QK_WIDTH, DIFF_V_WIDTH, D_MODEL, D_MODEL)
IN_COLS = sum(IN_WIDTHS)
SPLITS = tuple(int(c) for c in np.cumsum(IN_WIDTHS)[:-1])

kernel_name = 'hybrid_dilated_diff_attn_macaron'


def rms_norm(x, g):
    xf = x.astype(jnp.float32)
    y = xf * lax.rsqrt(jnp.mean(xf * xf, axis=-1, keepdims=True) + EPS)
    return (y * g.astype(jnp.float32)).astype(x.dtype)


def alibi_slopes(n):
    return jnp.exp2(-8.0 * jnp.arange(1, n + 1, dtype=jnp.float32) / n)


def swiglu_ffn(x, norm_g, w_in, w_out):
    h = rms_norm(x, norm_g)
    gate, up = jnp.split(h @ w_in, 2, axis=-1)
    return (jax.nn.silu(gate) * up) @ w_out


def dilated_window_attention(q, k, v, slopes, window, dilation):
    b, s, h, d = q.shape
    steps = window // dilation
    assert steps <= BLOCK
    span = dilation * BLOCK
    s_pad = -(-s // span) * span
    n_sub = s_pad // dilation
    n_blk = n_sub // BLOCK

    def to_blocks(t):
        t = jnp.pad(t, ((0, 0), (0, s_pad - s), (0, 0), (0, 0)))
        t = t.reshape(b, n_sub, dilation, h, d).transpose(0, 2, 1, 3, 4)
        return t.reshape(b, dilation, n_blk, BLOCK, h, d)

    def with_prev(t):
        prev = jnp.pad(t, ((0, 0), (0, 0), (1, 0), (0, 0), (0, 0), (0, 0)))[:, :, :-1]
        return jnp.concatenate([prev, t], axis=3)

    qb = to_blocks(q)
    kw = with_prev(to_blocks(k))
    vw = with_prev(to_blocks(v))
    logits = jnp.einsum('brnqhd,brnkhd->brnhqk', qb, kw).astype(jnp.float32)
    qi = jnp.arange(BLOCK)[:, None]
    ki = jnp.arange(2 * BLOCK)[None, :]
    dist = BLOCK + qi - ki
    key_sub = (jnp.arange(n_blk)[:, None, None] - 1) * BLOCK + ki[None]
    valid = (dist >= 0)[None] & (dist <= steps)[None] & (key_sub >= 0)
    bias = -slopes[:, None, None] * (dilation * dist).astype(jnp.float32)
    logits = jnp.where(valid[None, None, :, None], logits + bias, -jnp.inf)
    m = jnp.max(logits, axis=-1, keepdims=True)
    p = jnp.exp(logits - m)
    denom = jnp.sum(p, axis=-1, keepdims=True)
    out = jnp.einsum('brnhqk,brnkhd->brnqhd', p, vw.astype(jnp.float32))
    out = out / jnp.swapaxes(denom, 3, 4)
    lse = jnp.swapaxes((m + jnp.log(denom))[..., 0], 3, 4)
    out = out.reshape(b, dilation, n_sub, h, d).transpose(0, 2, 1, 3, 4).reshape(b, s_pad, h, d)[:, :s]
    lse = lse.reshape(b, dilation, n_sub, h).transpose(0, 2, 1, 3).reshape(b, s_pad, h)[:, :s]
    return out, lse


def differential_attention(q, k, v, slopes, lam):
    b, s, h, _, d = q.shape
    n_blk = s // BLOCK
    qb = q.reshape(b, n_blk, BLOCK, h, 2, d).transpose(1, 0, 2, 3, 4, 5)
    kpos = jnp.arange(s)
    vf = v.astype(jnp.float32)

    def one_block(args):
        q_blk, i = args
        qpos = i * BLOCK + jnp.arange(BLOCK)
        logits = jnp.einsum('bqhmd,bkhmd->bhmqk', q_blk, k).astype(jnp.float32)
        dist = qpos[:, None] - kpos[None, :]
        logits = logits - slopes[:, None, None, None] * dist.astype(jnp.float32)
        logits = jnp.where(dist >= 0, logits, -jnp.inf)
        p = jax.nn.softmax(logits, axis=-1)
        a = p[:, :, 0] - lam * p[:, :, 1]
        return jnp.einsum('bhqk,bkhe->bqhe', a, vf)

    out = lax.map(one_block, (qb, jnp.arange(n_blk)))
    return out.transpose(1, 0, 2, 3, 4).reshape(b, s, h, v.shape[-1])


def mixer_block(x, layer_idx, slopes, mix_norm, w_in, qk_gain_dil, qk_gain_diff, lambda_q, lambda_k,
                diff_subnorm, w_branch_dil, w_branch_diff, w_out):
    b, s, _ = x.shape
    h = rms_norm(x, mix_norm)
    proj = h @ w_in
    qa, ka, va, qd, kd, vd, gate_a, gate_b = jnp.split(proj, SPLITS, axis=-1)

    qa = rms_norm(qa.reshape(b, s, N_DIL_GROUPS, HEADS_PER_GROUP, HEAD_DIM), qk_gain_dil[0]) * HEAD_DIM ** -0.5
    ka = rms_norm(ka.reshape(b, s, N_DIL_GROUPS, HEADS_PER_GROUP, HEAD_DIM), qk_gain_dil[1])
    va = va.reshape(b, s, N_DIL_GROUPS, HEADS_PER_GROUP, HEAD_DIM)
    outs, lses = [], []
    for g, (window, dilation) in enumerate(DIL_CONFIGS):
        o_g, lse_g = dilated_window_attention(qa[:, :, g], ka[:, :, g], va[:, :, g],
                                              slopes[g * HEADS_PER_GROUP:(g + 1) * HEADS_PER_GROUP],
                                              window, dilation)
        outs.append(o_g)
        lses.append(lse_g)
    o_stack = jnp.stack(outs, axis=2)
    alpha = jax.nn.softmax(jnp.stack(lses, axis=2), axis=2)
    o_dil = jnp.sum(alpha[..., None] * o_stack, axis=2).reshape(b, s, DIL_OUT).astype(x.dtype)

    qd = rms_norm(qd.reshape(b, s, N_DIFF_HEADS, 2, HEAD_DIM), qk_gain_diff[0]) * HEAD_DIM ** -0.5
    kd = rms_norm(kd.reshape(b, s, N_DIFF_HEADS, 2, HEAD_DIM), qk_gain_diff[1])
    vd = vd.reshape(b, s, N_DIFF_HEADS, DIFF_V_DIM)
    lam_init = 0.8 - 0.6 * math.exp(-0.3 * layer_idx)
    lq = lambda_q.astype(jnp.float32)
    lk = lambda_k.astype(jnp.float32)
    lam = jnp.exp(jnp.sum(lq[0] * lk[0])) - jnp.exp(jnp.sum(lq[1] * lk[1])) + lam_init
    o_diff = differential_attention(qd, kd, vd, slopes[N_DIL_HEADS:], lam)
    o_diff = (rms_norm(o_diff, diff_subnorm) * (1.0 - lam_init)).reshape(b, s, DIFF_V_WIDTH).astype(x.dtype)

    y = jax.nn.sigmoid(gate_a) * (o_dil @ w_branch_dil) + jax.nn.sigmoid(gate_b) * (o_diff @ w_branch_diff)
    return y @ w_out


def setup_inputs(seed: int = 0) -> dict:
    key = jax.random.key(seed)
    ks = jax.random.split(key, 17)
    L, D, F = DEPTH, D_MODEL, D_FF
    f32 = jnp.float32

    def w(k, shape, fan_in):
        return jax.random.normal(k, shape, f32) * fan_in ** -0.5

    def gain(k, shape):
        return 1.0 + 0.02 * jax.random.normal(k, shape, f32)

    return {
        'x': jax.random.normal(ks[0], (BATCH, SEQ, D), f32),
        'ffn1_norm': gain(ks[1], (L, D)),
        'ffn1_w_in': w(ks[2], (L, D, 2 * F), D),
        'ffn1_w_out': w(ks[3], (L, F, D), F),
        'mix_norm': gain(ks[4], (L, D)),
        'w_in': w(ks[5], (L, D, IN_COLS), D),
        'qk_gain_dil': gain(ks[6], (L, 2, N_DIL_GROUPS, HEADS_PER_GROUP, HEAD_DIM)),
        'qk_gain_diff': gain(ks[7], (L, 2, N_DIFF_HEADS, 2, HEAD_DIM)),
        'lambda_q': 0.1 * jax.random.normal(ks[8], (L, 2, HEAD_DIM), f32),
        'lambda_k': 0.1 * jax.random.normal(ks[9], (L, 2, HEAD_DIM), f32),
        'diff_subnorm': gain(ks[10], (L, N_DIFF_HEADS, DIFF_V_DIM)),
        'w_branch_dil': w(ks[11], (L, DIL_OUT, D), DIL_OUT),
        'w_branch_diff': w(ks[12], (L, DIFF_V_WIDTH, D), DIFF_V_WIDTH),
        'w_out': w(ks[13], (L, D, D), D),
        'ffn2_norm': gain(ks[14], (L, D)),
        'ffn2_w_in': w(ks[15], (L, D, 2 * F), D),
        'ffn2_w_out': w(ks[16], (L, F, D), F),
    }


def reference(x, ffn1_norm, ffn1_w_in, ffn1_w_out, mix_norm, w_in, qk_gain_dil, qk_gain_diff,
              lambda_q, lambda_k, diff_subnorm, w_branch_dil, w_branch_diff, w_out,
              ffn2_norm, ffn2_w_in, ffn2_w_out):
    slopes = alibi_slopes(N_ALIBI_HEADS)
    for l in range(DEPTH):
        x = x + 0.5 * swiglu_ffn(x, ffn1_norm[l], ffn1_w_in[l], ffn1_w_out[l])
        x = x + mixer_block(x, l, slopes, mix_norm[l], w_in[l], qk_gain_dil[l], qk_gain_diff[l],
                            lambda_q[l], lambda_k[l], diff_subnorm[l], w_branch_dil[l],
                            w_branch_diff[l], w_out[l])
        x = x + 0.5 * swiglu_ffn(x, ffn2_norm[l], ffn2_w_in[l], ffn2_w_out[l])
    return x
```

```cpp
#include <hip/hip_runtime.h>
#include <hip/hip_cooperative_groups.h>
#include <cstdio>
#include <cstdint>
namespace cg = cooperative_groups;
namespace pg8 {
#define PG8_LAS __attribute__((address_space(3)))
typedef unsigned short bf16_t;
typedef short bf16x8 __attribute__((ext_vector_type(8)));
typedef float f32x4 __attribute__((ext_vector_type(4)));
typedef unsigned u32x4 __attribute__((ext_vector_type(4)));
constexpr int BM = 256, BK = 64, HALF = 128, HTB = HALF * BK * 2  , STAGE_BYTES = 8 * HTB, NXCD = 8, WGM = 8;

__host__ __device__ __forceinline__ int lds_byte(int r, int c) { const int st = (r >> 4) * 2 + (c >> 5), rr = r & 15, cc = c & 31, ob = rr * 64 + cc * 2; return st * 1024 + (ob ^ (((ob >> 9) & 1) << 5)); }
__host__ __device__ __forceinline__ void stage_rc(int b, int& R, int& C) { const int st = b / 1024, sb = b % 1024, swz = sb ^ (((sb >> 9) & 1) << 5); R = (st >> 1) * 16 + swz / 64; C = (st & 1) * 32 + (swz % 64) / 2; }
__host__ __device__ __forceinline__ int perm32(int rho) { const int n = rho >> 4, i = rho & 15; return 8 * (i >> 2) + 4 * n + (i & 3); }

struct Unit { int pm, pn; };
struct Gemm { const bf16_t* A; const bf16_t* Bt; int M, N, K; int lda; };

struct StaticOrder {
    int nM, nN, nwg, G, c;
    __host__ __device__ void init(int M, int N, int G_, int c_) { nM = M / BM; nN = N / BM; nwg = nM * nN; G = G_; c = c_; }
    __host__ __device__ bool next(int i, Unit& u) const {
        const long L = (long)i * G + c; if (L >= nwg) return false;
        int wgid = (int)L; { const int q = nwg / NXCD, r = nwg % NXCD, xcd = wgid % NXCD, off = wgid / NXCD; wgid = (xcd < r ? xcd * (q + 1) : r * (q + 1) + (xcd - r) * q) + off; }
        const int nig = WGM * nN, gid = wgid / nig, fm = gid * WGM, gsz = (nM - fm) < WGM ? (nM - fm) : WGM;
        u.pm = fm + ((wgid % nig) % gsz); u.pn = (wgid % nig) / gsz; return true;
    }
    __device__ __forceinline__ void a_ready(const Unit&) const {}
    __device__ __forceinline__ void done(const Unit&) const {}
};
__device__ __forceinline__ unsigned cvt_pk_bf16(float lo, float hi) { unsigned r; asm volatile("v_cvt_pk_bf16_f32 %0, %1, %2" : "=v"(r) : "v"(lo), "v"(hi)); return r; }
typedef float f32x2 __attribute__((ext_vector_type(2)));
template <class Epi, class Sched, bool ALIGN_EPI = false, bool SP2 = false>
__device__ __forceinline__ void gemm_phase(PG8_LAS unsigned char* lds, const Gemm g, const Sched& S, const Epi& E, const int wid_in) {
    int tid_; asm volatile("v_mbcnt_lo_u32_b32 %0, -1, 0\n\tv_mbcnt_hi_u32_b32 %0, -1, %0" : "=v"(tid_)); int wid_ = wid_in; asm volatile("" : "+s"(wid_)); tid_ += 64 * wid_; const int tid = tid_, wid = wid_, lane = tid & 63, wr = wid >> 2, wc = wid & 3, fr = lane & 15, fq = lane >> 4;
    const int K = g.K, nt = K / BK;
    unsigned voffA[2], voffB[2];
#pragma unroll
    for (int i = 0; i < 2; ++i) { int R, C; stage_rc(tid * 16 + i * 8192, R, C); const int Rb = Epi::PERM ? ((R & ~31) + perm32(R & 31)) : R;
        voffA[i] = (unsigned)(R * (g.lda ? g.lda : K) + C) * 2u; voffB[i] = (unsigned)(Rb * K + C) * 2u; }
    const size_t kstep = (size_t)(BK * 2);
    const size_t hstep = (size_t)HALF * K * 2;
    const size_t tstep = 2 * hstep;
    const int lda = g.lda ? g.lda : K;
    const size_t hstepA = (size_t)HALF * lda * 2, tstepA = 2 * hstepA;
    const unsigned ldsw = (unsigned)wid * 1024u;
    const int aoff = lds_byte(wr * 64 + fr, fq * 8), boff = lds_byte(wc * 32 + fr, fq * 8);
#define PG8_SA(b, h) (((b) * 2 + (h)) * HTB)
#define PG8_SB(b, h) ((4 + (b) * 2 + (h)) * HTB)
#define PG8_STAGE(bufoff, gbase, voff) do { _Pragma("unroll") for (int _i = 0; _i < 2; ++_i) \
        __builtin_amdgcn_global_load_lds((const unsigned*)((const char*)(gbase) + (voff)[_i]), (PG8_LAS unsigned*)(lds + (bufoff) + ldsw + _i * 8192), 16, 0, 0); } while (0)
#define PG8_LDA(dst, b, h) do { _Pragma("unroll") for (int m = 0; m < 4; ++m) _Pragma("unroll") for (int k = 0; k < 2; ++k) dst[m][k] = *(const PG8_LAS bf16x8*)(lds + PG8_SA(b, h) + aoff + m * 2048 + k * 1024); } while (0)
#define PG8_LDB(dst, b, h) do { _Pragma("unroll") for (int n = 0; n < 2; ++n) _Pragma("unroll") for (int k = 0; k < 2; ++k) dst[n][k] = *(const PG8_LAS bf16x8*)(lds + PG8_SB(b, h) + boff + n * 2048 + k * 1024); } while (0)
#define PG8_MMA(ai, bj, At, Bt) do { __builtin_amdgcn_s_setprio(1); _Pragma("unroll") for (int m = 0; m < 4; ++m) _Pragma("unroll") for (int n = 0; n < 2; ++n) _Pragma("unroll") for (int k = 0; k < 2; ++k) \
        acc[ai][bj][m][n] = __builtin_amdgcn_mfma_f32_16x16x32_bf16(Bt[n][k], At[m][k], acc[ai][bj][m][n], 0, 0, 0); __builtin_amdgcn_s_setprio(0); } while (0)
#define PG8_WAIT_V(n) asm volatile("s_waitcnt vmcnt(" #n ")" ::: "memory")
#define PG8_WAIT_L(n) asm volatile("s_waitcnt lgkmcnt(" #n ")" ::: "memory")
#define PG8_BAR __builtin_amdgcn_s_barrier()
#define PG8_SCHED __builtin_amdgcn_sched_barrier(0)
    Unit cur, nxt; int ui = 0;
    if (!S.next(0, cur)) return;
    f32x4 acc[2][2][4][2];
#pragma unroll
    for (int a = 0; a < 2; ++a)
#pragma unroll
        for (int b = 0; b < 2; ++b)
#pragma unroll
            for (int m = 0; m < 4; ++m)
#pragma unroll
                for (int n = 0; n < 2; ++n) acc[a][b][m][n] = (f32x4){0.f, 0.f, 0.f, 0.f};
    bf16x8 At[4][2], B0[2][2], B1[2][2];
    const char* cA = (const char*)g.A + (size_t)cur.pm * tstepA; const char* cB = (const char*)g.Bt + (size_t)cur.pn * tstep;
    S.a_ready(cur);
    if constexpr (SP2) {
        PG8_STAGE(PG8_SB(0, 0), cB, voffB); PG8_STAGE(PG8_SB(0, 1), cB + hstep, voffB); PG8_STAGE(PG8_SA(0, 0), cA, voffA); PG8_STAGE(PG8_SA(0, 1), cA + hstepA, voffA);
        if (wr == 1) PG8_BAR;
        PG8_WAIT_V(2); PG8_BAR;
        PG8_STAGE(PG8_SB(1, 0), cB + kstep, voffB); PG8_STAGE(PG8_SA(1, 0), cA + kstep, voffA); PG8_STAGE(PG8_SB(1, 1), cB + hstep + kstep, voffB);
        PG8_WAIT_V(6); PG8_BAR;
    } else {
        PG8_STAGE(PG8_SB(0, 0), cB, voffB); PG8_STAGE(PG8_SA(0, 0), cA, voffA); PG8_STAGE(PG8_SB(0, 1), cB + hstep, voffB); PG8_STAGE(PG8_SA(0, 1), cA + hstepA, voffA);
        if (wr == 1) PG8_BAR;
        PG8_WAIT_V(4); PG8_BAR;
        PG8_STAGE(PG8_SB(1, 0), cB + kstep, voffB); PG8_STAGE(PG8_SA(1, 0), cA + kstep, voffA); PG8_STAGE(PG8_SB(1, 1), cB + hstep + kstep, voffB);
        PG8_WAIT_V(6); PG8_BAR;
    }
    for (;;) {
        const bool has_next = S.next(ui + 1, nxt);
        const char* nA = has_next ? (const char*)g.A + (size_t)nxt.pm * tstepA : cA; const char* nB = has_next ? (const char*)g.Bt + (size_t)nxt.pn * tstep : cB;
        for (int t = 0; t < nt; t += 2) {
            const bool last = (t == nt - 2);
            const char* a1 = cA + (size_t)(t + 1) * kstep;
            const char* a2 = last ? nA : cA + (size_t)(t + 2) * kstep; const char* b2 = last ? nB : cB + (size_t)(t + 2) * kstep;
            const char* a3 = a2 + kstep; const char* b3 = b2 + kstep;
            if (last && has_next) S.a_ready(nxt);
            if constexpr (SP2) {
            PG8_LDB(B0, 0, 0); PG8_LDB(B1, 0, 1); PG8_SCHED; PG8_LDA(At, 0, 0); PG8_STAGE(PG8_SA(1, 1), a1 + hstepA, voffA);
            PG8_WAIT_V(8); PG8_WAIT_L(0); PG8_BAR; PG8_MMA(0, 0, At, B0); PG8_MMA(0, 1, At, B1); PG8_BAR; PG8_SCHED;
            PG8_LDA(At, 0, 1); PG8_STAGE(PG8_SB(0, 0), b2, voffB); PG8_STAGE(PG8_SB(0, 1), b2 + hstep, voffB); PG8_STAGE(PG8_SA(0, 0), a2, voffA);
            PG8_WAIT_V(8); PG8_WAIT_L(0); PG8_BAR; PG8_MMA(1, 0, At, B0); PG8_MMA(1, 1, At, B1); PG8_BAR; PG8_SCHED;
            PG8_LDB(B0, 1, 0); PG8_LDB(B1, 1, 1); PG8_SCHED; PG8_LDA(At, 1, 0); PG8_STAGE(PG8_SA(0, 1), a2 + hstepA, voffA);
            PG8_WAIT_V(8); PG8_WAIT_L(0); PG8_BAR; PG8_MMA(0, 0, At, B0); PG8_MMA(0, 1, At, B1); PG8_BAR; PG8_SCHED;
            PG8_LDA(At, 1, 1); PG8_STAGE(PG8_SB(1, 0), b3, voffB); PG8_STAGE(PG8_SB(1, 1), b3 + hstep, voffB); PG8_STAGE(PG8_SA(1, 0), a3, voffA);
            PG8_WAIT_V(8); PG8_WAIT_L(0); PG8_BAR; PG8_MMA(1, 0, At, B0); PG8_MMA(1, 1, At, B1); PG8_BAR; PG8_SCHED;
            } else {
            PG8_LDB(B0, 0, 0); PG8_SCHED; PG8_LDA(At, 0, 0); PG8_STAGE(PG8_SA(1, 1), a1 + hstepA, voffA);
            PG8_WAIT_L(8); PG8_BAR; PG8_WAIT_L(0); PG8_MMA(0, 0, At, B0); PG8_BAR; PG8_SCHED;
            PG8_LDB(B1, 0, 1); PG8_STAGE(PG8_SB(0, 0), b2, voffB);
            PG8_BAR; PG8_WAIT_L(0); PG8_MMA(0, 1, At, B1); PG8_BAR;
            PG8_LDA(At, 0, 1); PG8_STAGE(PG8_SA(0, 0), a2, voffA);
            PG8_BAR; PG8_WAIT_L(0); PG8_MMA(1, 0, At, B0); PG8_BAR; PG8_SCHED;
            PG8_STAGE(PG8_SB(0, 1), b2 + hstep, voffB);
            PG8_WAIT_V(6); PG8_BAR; PG8_MMA(1, 1, At, B1); PG8_BAR;
            PG8_LDB(B0, 1, 0); PG8_SCHED; PG8_LDA(At, 1, 0); PG8_STAGE(PG8_SA(0, 1), a2 + hstepA, voffA);
            PG8_WAIT_L(8); PG8_BAR; PG8_WAIT_L(0); PG8_MMA(0, 0, At, B0); PG8_BAR; PG8_SCHED;
            PG8_LDB(B1, 1, 1); PG8_STAGE(PG8_SB(1, 0), b3, voffB);
            PG8_BAR; PG8_WAIT_L(0); PG8_MMA(0, 1, At, B1); PG8_BAR;
            PG8_LDA(At, 1, 1); PG8_STAGE(PG8_SA(1, 0), a3, voffA);
            PG8_BAR; PG8_WAIT_L(0); PG8_MMA(1, 0, At, B0); PG8_BAR; PG8_SCHED;
            PG8_STAGE(PG8_SB(1, 1), b3 + hstep, voffB);
            PG8_WAIT_V(6); PG8_BAR; PG8_MMA(1, 1, At, B1); PG8_BAR;
            }
        }
        if constexpr (ALIGN_EPI) { if (wr == 0) PG8_BAR; }
        if constexpr (!Epi::AFTER_DRAIN) { int l2_; asm volatile("v_mbcnt_lo_u32_b32 %0, -1, 0\n\tv_mbcnt_hi_u32_b32 %0, -1, %0" : "=v"(l2_)); const int fr_ = l2_ & 15, fq_ = l2_ >> 4; E(acc, cur, wr, wc, fr_, fq_); S.done(cur); }
        if (!has_next) break;
#pragma unroll
        for (int a = 0; a < 2; ++a)
#pragma unroll
            for (int b = 0; b < 2; ++b)
#pragma unroll
                for (int m = 0; m < 4; ++m)
#pragma unroll
                    for (int n = 0; n < 2; ++n) acc[a][b][m][n] = (f32x4){0.f, 0.f, 0.f, 0.f};
        cur = nxt; cA = nA; cB = nB; ++ui;
        if constexpr (ALIGN_EPI) { if (wr == 1) PG8_BAR; }
    }
    PG8_WAIT_V(0);
    if constexpr (!ALIGN_EPI) { if (wr == 0) PG8_BAR; }
    PG8_BAR;
    if constexpr (Epi::AFTER_DRAIN) { E.fused(acc, cur, wr, wc, fr, fq, lds, wid, lane); S.done(cur); }
#undef PG8_SA
#undef PG8_SB
#undef PG8_STAGE
#undef PG8_LDA
#undef PG8_LDB
#undef PG8_MMA
#undef PG8_WAIT_V
#undef PG8_WAIT_L
#undef PG8_BAR
#undef PG8_SCHED
}
}

constexpr int M = 16384, DM = 1024, FF = 2816, SEQ = 2048, NPROJ = 5888;
constexpr float EPS = 1e-6f, LOG2E = 1.4426950408889634f;
constexpr float QSCALE = 0.125f * LOG2E;
#define LAS __attribute__((address_space(3)))
typedef unsigned short bf16;
typedef unsigned v4u __attribute__((ext_vector_type(4)));
using pg8::f32x4;

constexpr size_t MiB = 1u << 20;
constexpr size_t WS_LSE = 0;
constexpr size_t WS_SS = 251 * MiB;
constexpr size_t WS_CTR = 1 * MiB + 512 * 1024;
constexpr size_t WS_BND = 1 * MiB + 640 * 1024;
constexpr size_t WS_BAR = 1 * MiB + 768 * 1024;
constexpr size_t WS_WFI = 2 * MiB;
constexpr size_t WS_WFO = 13 * MiB;
constexpr size_t WS_WPR = 19 * MiB;
constexpr size_t WS_WA = 31 * MiB;
constexpr size_t WS_WB = 31 * MiB + 512 * 1024;
constexpr size_t WS_WO = 33 * MiB;
constexpr size_t WS_XN = 35 * MiB;
constexpr size_t WS_P = 67 * MiB;
constexpr size_t WS_QA = WS_P, WS_KA = WS_QA + 24 * MiB, WS_VA = WS_KA + 24 * MiB;
constexpr size_t WS_QD = WS_VA + 24 * MiB, WS_KD = WS_QD + 16 * MiB, WS_VD = WS_KD + 16 * MiB;
constexpr size_t WS_GA = WS_VD + 16 * MiB, WS_GB = WS_GA + 32 * MiB;
constexpr size_t WS_H = WS_P;
constexpr size_t WS_ODIL = WS_QA;
constexpr size_t WS_Y = WS_GA;
constexpr size_t WS_WFI_ALT = 156 * MiB, WS_WFO_ALT = 168 * MiB;
constexpr size_t WS_END = WS_GB + 32 * MiB;
static_assert(WS_END == 251 * MiB && WS_SS + 2 * MiB <= 256 * MiB && WS_H + (size_t)88 * MiB <= WS_WFI_ALT && WS_WFO_ALT + 6 * MiB <= WS_END, "ws map");

__device__ __forceinline__ int lane_id() { int l; asm volatile("v_mbcnt_lo_u32_b32 %0, -1, 0\n\tv_mbcnt_hi_u32_b32 %0, -1, %0" : "=v"(l)); return l; }
__device__ __forceinline__ int launder(int v) { asm volatile("" : "+v"(v)); return v; }
__device__ __forceinline__ float bf2f(unsigned short b) { return __uint_as_float(((unsigned)b) << 16); }
__device__ __forceinline__ unsigned f2bf(float f) { unsigned u = __float_as_uint(f); return (u + 0x7fffu + ((u >> 16) & 1u)) >> 16; }
__device__ __forceinline__ unsigned pk2(float lo, float hi) { return f2bf(lo) | (f2bf(hi) << 16); }
__device__ __forceinline__ float shfl_xor_f(float v, int mask) {
    int l; asm volatile("v_mbcnt_lo_u32_b32 %0, -1, 0\n\tv_mbcnt_hi_u32_b32 %0, -1, %0" : "=v"(l));
    return __int_as_float(__builtin_amdgcn_ds_bpermute((l ^ mask) << 2, __float_as_int(v)));
}
__device__ __forceinline__ float wave_sum(float v) {
#pragma unroll
    for (int o = 1; o < 64; o <<= 1) v += shfl_xor_f(v, o);
    return v;
}
__device__ __forceinline__ float wave_max(float v) {
#pragma unroll
    for (int o = 1; o < 64; o <<= 1) v = fmaxf(v, shfl_xor_f(v, o));
    return v;
}
__device__ __forceinline__ float fast_exp2(float x) { return __builtin_amdgcn_exp2f(x); }
__device__ __forceinline__ float fast_rcp(float x) { return __builtin_amdgcn_rcpf(x); }
__device__ __forceinline__ float sigmoidf_(float x) { return fast_rcp(1.0f + fast_exp2(-x * LOG2E)); }

using pg8::u32x4; using pg8::bf16_t; using pg8::Unit; using pg8::HALF; using pg8::BM; using pg8::cvt_pk_bf16;

__device__ __forceinline__ float row_rstd(const float* SS, int row) {
    const f32x4* p = (const f32x4*)(SS + (size_t)row * 16);
    const f32x4 a = p[0], b = p[1], c = p[2], d = p[3];
    const float t = (((a[0] + a[1]) + (a[2] + a[3])) + ((b[0] + b[1]) + (b[2] + b[3]))) + (((c[0] + c[1]) + (c[2] + c[3])) + ((d[0] + d[1]) + (d[2] + d[3])));
    return rsqrtf(t * (1.0f / DM) + EPS);
}
struct EpiSwiGLU {
    static constexpr bool PERM = true, AFTER_DRAIN = false;
    bf16_t* H; const float* SS;
    __device__ __forceinline__ void operator()(const f32x4 (&acc)[2][2][4][2], const Unit& u, int wr, int wc, int fr, int fq) const {
        const int row0 = u.pm * BM + wr * 64 + fr, col0 = u.pn * 128 + wc * 32 + 8 * fq;
#pragma unroll
        for (int ai = 0; ai < 2; ++ai)
#pragma unroll
            for (int m = 0; m < 4; ++m) {
                float h[8];
                const float rs = row_rstd(SS, row0 + ai * HALF + m * 16);
                const float na = -rs * LOG2E, rs2 = rs * rs;
#pragma unroll
                for (int n = 0; n < 2; ++n)
#pragma unroll
                    for (int e = 0; e < 4; e += 2) {
                        typedef float f32x2 __attribute__((ext_vector_type(2)));
                        const f32x2 g = (f32x2){acc[ai][0][m][n][e], acc[ai][0][m][n][e + 1]}, up = (f32x2){acc[ai][1][m][n][e], acc[ai][1][m][n][e + 1]};
                        const f32x2 t = g * na; f32x2 ex; ex.x = fast_exp2(t.x); ex.y = fast_exp2(t.y);
                        const f32x2 d = ex + 1.0f; f32x2 r; r.x = fast_rcp(d.x); r.y = fast_rcp(d.y);
                        const f32x2 hv = (g * up) * rs2 * r;
                        h[n * 4 + e] = hv.x; h[n * 4 + e + 1] = hv.y;
                    }
                u32x4 w; w.x = cvt_pk_bf16(h[0], h[1]); w.y = cvt_pk_bf16(h[2], h[3]); w.z = cvt_pk_bf16(h[4], h[5]); w.w = cvt_pk_bf16(h[6], h[7]);
                *(u32x4*)(H + (size_t)(row0 + ai * HALF + m * 16) * FF + col0) = w;
            }
    }
};
struct EpiResid {
    static constexpr bool PERM = true, AFTER_DRAIN = false;
    float* xout; bf16_t* XB; float* SSn; float s; int last;
    __device__ __forceinline__ void operator()(const f32x4 (&acc)[2][2][4][2], const Unit& u, int wr, int wc, int fr, int fq) const {
        const int row0 = u.pm * BM + wr * 64 + fr, col0 = u.pn * BM + wc * 32 + 8 * fq;
#pragma unroll
        for (int ai = 0; ai < 2; ++ai)
#pragma unroll
            for (int m = 0; m < 4; ++m) {
                float ss = 0.f;
#pragma unroll
                for (int bj = 0; bj < 2; ++bj) {
                    const size_t off = (size_t)(row0 + ai * HALF + m * 16) * DM + col0 + bj * HALF;
                    const u32x4 xw = *(const u32x4*)(XB + off);
                    f32x4 y0, y1;
                    y0[0] = __uint_as_float(xw.x << 16); y0[1] = __uint_as_float(xw.x & 0xffff0000u); y0[2] = __uint_as_float(xw.y << 16); y0[3] = __uint_as_float(xw.y & 0xffff0000u);
                    y1[0] = __uint_as_float(xw.z << 16); y1[1] = __uint_as_float(xw.z & 0xffff0000u); y1[2] = __uint_as_float(xw.w << 16); y1[3] = __uint_as_float(xw.w & 0xffff0000u);
                    y0 = y0 + acc[ai][bj][m][0] * s; y1 = y1 + acc[ai][bj][m][1] * s;
                    if (last) { *(f32x4*)(xout + off) = y0; *(f32x4*)(xout + off + 4) = y1; }
                    else {
                        u32x4 w; w.x = cvt_pk_bf16(y0[0], y0[1]); w.y = cvt_pk_bf16(y0[2], y0[3]); w.z = cvt_pk_bf16(y1[0], y1[1]); w.w = cvt_pk_bf16(y1[2], y1[3]);
                        *(u32x4*)(XB + off) = w;
                        ss += (y0[0] * y0[0] + y0[1] * y0[1]) + (y0[2] * y0[2] + y0[3] * y0[3]) + (y1[0] * y1[0] + y1[1] * y1[1]) + (y1[2] * y1[2] + y1[3] * y1[3]);
                    }
                }
                if (!last) { ss += shfl_xor_f(ss, 16); ss += shfl_xor_f(ss, 32); if (fq == 0) SSn[(size_t)(row0 + ai * HALF + m * 16) * 16 + u.pn * 4 + wc] = ss; }
            }
    }
};
struct EpiProj {
    static constexpr bool PERM = true, AFTER_DRAIN = false;
    unsigned char* ws; const float* gdil; const float* gdiff; const float* SS;
    __device__ __forceinline__ void operator()(const f32x4 (&acc)[2][2][4][2], const Unit& u, int wr, int wc, int fr, int fq) const {
        const int pn = u.pn;
        bf16_t* dst; int ld, ct, mode; const float* gain = nullptr; float sc = 1.f;
        if (pn < 3)       { dst = (bf16_t*)(ws + WS_QA); ld = 768;  ct = pn;      mode = 1; gain = gdil;        sc = QSCALE; }
        else if (pn < 6)  { dst = (bf16_t*)(ws + WS_KA); ld = 768;  ct = pn - 3;  mode = 1; gain = gdil + 768; }
        else if (pn < 9)  { dst = (bf16_t*)(ws + WS_VA); ld = 768;  ct = pn - 6;  mode = 0; }
        else if (pn < 11) { dst = (bf16_t*)(ws + WS_QD); ld = 512;  ct = pn - 9;  mode = 1; gain = gdiff;       sc = QSCALE; }
        else if (pn < 13) { dst = (bf16_t*)(ws + WS_KD); ld = 512;  ct = pn - 11; mode = 1; gain = gdiff + 512; }
        else if (pn < 15) { dst = (bf16_t*)(ws + WS_VD); ld = 512;  ct = pn - 13; mode = 0; }
        else if (pn < 19) { dst = (bf16_t*)(ws + WS_GA); ld = 1024; ct = pn - 15; mode = 2; }
        else              { dst = (bf16_t*)(ws + WS_GB); ld = 1024; ct = pn - 19; mode = 2; }
        const int colw = ct * 256 + wc * 64 + 8 * fq;
        const int row0 = u.pm * BM + wr * 64 + fr;
        f32x4 gv[2][2];
#pragma unroll
        for (int bj = 0; bj < 2; ++bj)
#pragma unroll
            for (int n = 0; n < 2; ++n) gv[bj][n] = (mode == 1) ? *(const f32x4*)(gain + colw + 32 * bj + 4 * n) * sc : (f32x4){1.f, 1.f, 1.f, 1.f};
#pragma unroll
        for (int ai = 0; ai < 2; ++ai)
#pragma unroll
            for (int m = 0; m < 4; ++m) {
                f32x4 v[2][2];
                const float rs = row_rstd(SS, row0 + ai * HALF + m * 16);
#pragma unroll
                for (int bj = 0; bj < 2; ++bj)
#pragma unroll
                    for (int n = 0; n < 2; ++n) v[bj][n] = acc[ai][bj][m][n] * rs;
                if (mode == 1) {
                    float ss = 0.f;
#pragma unroll
                    for (int bj = 0; bj < 2; ++bj)
#pragma unroll
                        for (int n = 0; n < 2; ++n) { const f32x4 x = v[bj][n]; ss += (x[0] * x[0] + x[1] * x[1]) + (x[2] * x[2] + x[3] * x[3]); }
                    ss += shfl_xor_f(ss, 16); ss += shfl_xor_f(ss, 32);
                    const float r = rsqrtf(ss * (1.0f / 64.0f) + EPS);
#pragma unroll
                    for (int bj = 0; bj < 2; ++bj)
#pragma unroll
                        for (int n = 0; n < 2; ++n) v[bj][n] = v[bj][n] * r * gv[bj][n];
                } else if (mode == 2) {
                    const float na = -rs * LOG2E;
#pragma unroll
                    for (int bj = 0; bj < 2; ++bj)
#pragma unroll
                        for (int n = 0; n < 2; ++n) {
                            const f32x4 t = acc[ai][bj][m][n] * na; f32x4 ex;
#pragma unroll
                            for (int e = 0; e < 4; ++e) ex[e] = fast_exp2(t[e]);
                            const f32x4 d = ex + 1.0f;
#pragma unroll
                            for (int e = 0; e < 4; ++e) v[bj][n][e] = fast_rcp(d[e]);
                        }
                }
                bf16_t* rowp = dst + (size_t)(row0 + ai * HALF + m * 16) * ld + colw;
#pragma unroll
                for (int bj = 0; bj < 2; ++bj) {
                    u32x4 w; w.x = cvt_pk_bf16(v[bj][0][0], v[bj][0][1]); w.y = cvt_pk_bf16(v[bj][0][2], v[bj][0][3]); w.z = cvt_pk_bf16(v[bj][1][0], v[bj][1][1]); w.w = cvt_pk_bf16(v[bj][1][2], v[bj][1][3]);
                    *(u32x4*)(rowp + 32 * bj) = w;
                }
            }
    }
};
template <int PASS> struct EpiMerge {
    static constexpr bool PERM = true, AFTER_DRAIN = false;
    bf16_t* Y; const bf16_t* gate;
    __device__ __forceinline__ void operator()(const f32x4 (&acc)[2][2][4][2], const Unit& u, int wr, int wc, int fr, int fq) const {
        const int row0 = u.pm * BM + wr * 64 + fr, col0 = u.pn * BM + wc * 32 + 8 * fq;
#pragma unroll
        for (int ai = 0; ai < 2; ++ai)
#pragma unroll
            for (int m = 0; m < 4; ++m)
#pragma unroll
                for (int bj = 0; bj < 2; ++bj) {
                    const size_t off = (size_t)(row0 + ai * HALF + m * 16) * DM + col0 + bj * HALF;
                    const u32x4 gw = *(const u32x4*)(gate + off);
                    float y[8];
#pragma unroll
                    for (int n = 0; n < 2; ++n)
#pragma unroll
                        for (int e = 0; e < 4; ++e) {
                            const unsigned word = gw[n * 2 + (e >> 1)]; const float g = __uint_as_float((e & 1) ? (word & 0xffff0000u) : (word << 16));
                            y[n * 4 + e] = g * acc[ai][bj][m][n][e];
                        }
                    if (PASS == 2) {
                        const u32x4 yw = *(const u32x4*)(Y + off);
#pragma unroll
                        for (int i = 0; i < 8; ++i) { const unsigned word = yw[i >> 1]; y[i] += __uint_as_float((i & 1) ? (word & 0xffff0000u) : (word << 16)); }
                    }
                    u32x4 w; w.x = cvt_pk_bf16(y[0], y[1]); w.y = cvt_pk_bf16(y[2], y[3]); w.z = cvt_pk_bf16(y[4], y[5]); w.w = cvt_pk_bf16(y[6], y[7]);
                    *(u32x4*)(Y + off) = w;
                }
    }
};

template <int MODE> __device__ __forceinline__ int colmap(int n0) {
    if (MODE == 0) return n0;
    const int pn = n0 >> 8, r = n0 & 255, bj = r >> 7, wc = (r & 127) >> 5;
    if (MODE == 1) return bj * FF + 128 * pn + 32 * wc;
    return 256 * pn + 64 * wc + 32 * bj;
}
template <int MODE> __device__ __forceinline__ void convert_item(const float* W, const float* g, int K, int Nsrc, int Nphys, bf16* WT, LAS float* scr, int item, int lane) {
    const int nblk = Nphys / 32;
    const int kb = item / nblk, nb = item % nblk, k0 = 64 * kb, n0 = 32 * nb, s0 = colmap<MODE>(n0);
    {
        const int kr = lane >> 3, c4 = lane & 7;
        const float* src = W + (size_t)(k0 + kr) * Nsrc + s0 + 4 * c4;
        f32x4 v[8];
#pragma unroll
        for (int i = 0; i < 8; ++i) v[i] = *(const f32x4*)(src + (size_t)(8 * i) * Nsrc);
        if (g) {
#pragma unroll
            for (int i = 0; i < 8; ++i) v[i] = v[i] * g[k0 + 8 * i + kr];
        }
#pragma unroll
        for (int i = 0; i < 8; ++i) { LAS float* d = scr + (8 * i + kr) * 33 + 4 * c4; d[0] = v[i][0]; d[1] = v[i][1]; d[2] = v[i][2]; d[3] = v[i][3]; }
    }
    asm volatile("s_waitcnt lgkmcnt(0)" ::: "memory");
    const int c = lane & 7;
#pragma unroll
    for (int j = 0; j < 4; ++j) { const int n = (lane >> 3) + 8 * j; const LAS float* s = scr + (8 * c) * 33 + n;
        v4u o; o.x = pk2(s[0 * 33], s[1 * 33]); o.y = pk2(s[2 * 33], s[3 * 33]); o.z = pk2(s[4 * 33], s[5 * 33]); o.w = pk2(s[6 * 33], s[7 * 33]);
        *(v4u*)(WT + (size_t)(n0 + n) * K + k0 + 8 * c) = o; }
    asm volatile("s_waitcnt lgkmcnt(0)" ::: "memory");
}
template <int MODE> __device__ __forceinline__ void convert_weight(const float* W, const float* g, int K, int Nsrc, int Nphys, bf16* WT, LAS float* scr, int gw, int NGW, int lane_in) {
    const int lane = launder(lane_in);
    const int nitems = (K / 64) * (Nphys / 32);
    for (int item = gw; item < nitems; item += NGW) convert_item<MODE>(W, g, K, Nsrc, Nphys, WT, scr, item, lane);
}
__device__ __forceinline__ int grab_item(unsigned* ctr, int lane) {
    unsigned v = 0; if (lane == 0) v = atomicAdd(ctr, 1u);
    return __builtin_amdgcn_readfirstlane((int)v);
}
__device__ __forceinline__ void ffn_jobs(unsigned* ctr, const float* wi, const float* g, const float* wo, bf16* WFIu, bf16* WFOu, LAS float* scr, int lane_in) {
    const int lane = launder(lane_in);
    constexpr int N0 = (DM / 64) * (2 * FF / 32), N1 = (FF / 64) * (DM / 32);
    for (;;) { const int it = grab_item(ctr, lane); if (it >= N0 + N1) break;
        if (it < N0) convert_item<1>(wi, g, DM, 2 * FF, 2 * FF, WFIu, scr, it, lane); else convert_item<0>(wo, nullptr, FF, DM, DM, WFOu, scr, it - N0, lane); }
}
__device__ __forceinline__ void mixer_jobs(unsigned* ctr, const float* win, const float* g, const float* wa, const float* wb, const float* wo, unsigned char* ws, LAS float* scr, int lane_in) {
    const int lane = launder(lane_in);
    constexpr int N0 = (DM / 64) * (NPROJ / 32), N1 = (256 / 64) * (DM / 32), N2 = (512 / 64) * (DM / 32), N3 = (DM / 64) * (DM / 32);
    for (;;) { int it = grab_item(ctr, lane); if (it >= N0 + N1 + N2 + N3) break;
        if (it < N0) { convert_item<2>(win, g, DM, NPROJ, NPROJ, (bf16*)(ws + WS_WPR), scr, it, lane); continue; } it -= N0;
        if (it < N1) { convert_item<0>(wa, nullptr, 256, DM, DM, (bf16*)(ws + WS_WA), scr, it, lane); continue; } it -= N1;
        if (it < N2) { convert_item<0>(wb, nullptr, 512, DM, DM, (bf16*)(ws + WS_WB), scr, it, lane); continue; } it -= N2;
        convert_item<0>(wo, nullptr, DM, DM, DM, (bf16*)(ws + WS_WO), scr, it, lane); }
}
__device__ __forceinline__ void prologue_rows(const float* x, bf16* XB, float* SS0, int gw, int NGW, int lane_in) {
    const int lane = launder(lane_in);
    for (int m0 = gw; m0 < M; m0 += 4 * NGW) {
        f32x4 v[4][4];
#pragma unroll
        for (int q = 0; q < 4; ++q) { const int m = m0 + q * NGW; if (m < M) { const f32x4* xr = (const f32x4*)(x + (size_t)m * DM) + lane;
#pragma unroll
            for (int j = 0; j < 4; ++j) v[q][j] = xr[64 * j]; } }
#pragma unroll
        for (int q = 0; q < 4; ++q) { const int m = m0 + q * NGW; if (m < M) {
            float s = 0.f;
#pragma unroll
            for (int j = 0; j < 4; ++j) s += (v[q][j].x * v[q][j].x + v[q][j].y * v[q][j].y) + (v[q][j].z * v[q][j].z + v[q][j].w * v[q][j].w);
            s = wave_sum(s);
            unsigned long long* o8 = (unsigned long long*)(XB + (size_t)m * DM) + lane;
#pragma unroll
            for (int j = 0; j < 4; ++j) o8[64 * j] = (unsigned long long)pk2(v[q][j].x, v[q][j].y) | ((unsigned long long)pk2(v[q][j].z, v[q][j].w) << 32);
            if (lane < 16) SS0[(size_t)m * 16 + lane] = (lane == 0) ? s : 0.f; } }
    }
}
namespace att {
typedef short bf16x8 __attribute__((ext_vector_type(8)));
typedef short s16x4 __attribute__((ext_vector_type(4)));
typedef float f32x16 __attribute__((ext_vector_type(16)));
constexpr int KP = 144, VP64 = 192, VP128 = 320, STAGE = 43008, OFF_K1 = 9216, OFF_V = 18432, V1STEP = 12288;
struct UnitP {
    const bf16* Q; const bf16* K; const bf16* V; bf16* O;
    int pitch, scol;
    int qrow0, krow0, rs;
    int t0, t1;
    int D0, maxdist;
    float c0, c1;
    float lam, onem; const float* sub;
    float* lse; int lsecol;
    float bnd0, bnd1;
};
__device__ __forceinline__ s16x4 vtr(const LAS unsigned char* p) {
    typedef short v4i16_t __attribute__((ext_vector_type(4)));
    return __builtin_bit_cast(s16x4, __builtin_amdgcn_ds_read_tr16_b64_v4i16((LAS v4i16_t*)p));
}
__device__ __forceinline__ unsigned cvtpk(float lo, float hi) { unsigned r; asm volatile("v_cvt_pk_bf16_f32 %0, %1, %2" : "=v"(r) : "v"(lo), "v"(hi)); return r; }
__device__ __forceinline__ bf16x8 pack8(float a, float b, float c, float d, float e, float f, float g, float h) {
    v4u w; w.x = cvtpk(a, b); w.y = cvtpk(c, d); w.z = cvtpk(e, f); w.w = cvtpk(g, h); return __builtin_bit_cast(bf16x8, w);
}
template <bool DIFF, bool FAST>
__device__ __forceinline__ void attn_unit(LAS unsigned char* lds, const UnitP& P, const int wave, const int lane_in) {
    const int lane = launder(lane_in);
    constexpr int NDB = DIFF ? 4 : 2, VP = DIFF ? VP128 : VP64;
    const int sidx = wave >> 2, w4 = wave & 3, r32 = lane & 31, hi = lane >> 5, tid = wave * 64 + lane;
    const int qidx = 32 * w4 + r32;
    bf16x8 qf[4];
    { const bf16* qp = P.Q + (size_t)(P.qrow0 + qidx * P.rs) * P.pitch + sidx * P.scol + hi * 8;
#pragma unroll
      for (int ks = 0; ks < 4; ++ks) qf[ks] = *(const bf16x8*)(qp + ks * 16); }
    const size_t tstep = (size_t)64 * P.rs * P.pitch;
    const bf16* kg; const bf16* vg; int kl, vl;
    { const int ss = tid >> 8, u = tid & 255, kk = u >> 2, cp = u & 3;
      kg = P.K + ss * P.scol + cp * 16 + (long long)(P.krow0 + kk * P.rs) * P.pitch; kl = ss * OFF_K1 + kk * KP + cp * 32;
      if (DIFF) { const int kkv = tid >> 3, cpv = tid & 7; vg = P.V + cpv * 16 + (long long)(P.krow0 + kkv * P.rs) * P.pitch; vl = OFF_V + kkv * VP128 + cpv * 32; }
      else { vg = P.V + ss * P.scol + cp * 16 + (long long)(P.krow0 + kk * P.rs) * P.pitch; vl = OFF_V + ss * V1STEP + kk * VP64 + cp * 32; } }
    v4u rk0, rk1, rv0, rv1;
#define ATT_LOADT(t) do { const bf16* a_ = kg + (size_t)(t) * tstep; rk0 = *(const v4u*)a_; rk1 = *(const v4u*)(a_ + 8); const bf16* b_ = vg + (size_t)(t) * tstep; rv0 = *(const v4u*)b_; rv1 = *(const v4u*)(b_ + 8); } while (0)
#define ATT_STORET(st) do { LAS unsigned char* base_ = lds + (st) * STAGE; *(LAS v4u*)(base_ + kl) = rk0; *(LAS v4u*)(base_ + kl + 16) = rk1; *(LAS v4u*)(base_ + vl) = rv0; *(LAS v4u*)(base_ + vl + 16) = rv1; } while (0)
    float m_run = -INFINITY, l_run = 0.f;
    f32x16 o[NDB];
#pragma unroll
    for (int db = 0; db < NDB; ++db)
#pragma unroll
        for (int r = 0; r < 16; ++r) o[db][r] = 0.f;
    const float c = sidx ? P.c1 : P.c0;
    const float maxdf = (float)P.maxdist;
    const float bnd = sidx ? P.bnd1 : P.bnd0;
    f32x16 pat0, pat1;
    if (FAST) {
#pragma unroll
        for (int r = 0; r < 16; ++r) { pat0[r] = c * (float)((r & 3) + 8 * (r >> 2)); pat1[r] = pat0[r] + 32.f * c; }
    }
    ATT_LOADT(P.t0); ATT_STORET(0); __syncthreads();
    int stg = 0;
    for (int t = P.t0; t < P.t1; ++t) {
        const bool more = (t + 1 < P.t1);
        if (more) ATT_LOADT(t + 1);
        const int dbw = P.D0 - 64 * t + 32 * w4;
        if (dbw + 31 >= 0 && dbw - 63 <= P.maxdist) {
            const LAS unsigned char* Kt = lds + stg * STAGE + sidx * OFF_K1;
            const LAS unsigned char* Vt = lds + stg * STAGE + OFF_V + (DIFF ? 0 : sidx * V1STEP);
            f32x16 p0, p1;
            const LAS unsigned char* ka = Kt + r32 * KP + hi * 16;
            const float dl = (float)(dbw + r32 - 4 * hi);
            if (FAST) {
#pragma unroll
                for (int ks = 0; ks < 4; ++ks) {
                    const bf16x8 k0 = *(const LAS bf16x8*)(ka + ks * 32), k1 = *(const LAS bf16x8*)(ka + 32 * KP + ks * 32);
                    p0 = __builtin_amdgcn_mfma_f32_32x32x16_bf16(k0, qf[ks], ks == 0 ? pat0 : p0, 0, 0, 0);
                    p1 = __builtin_amdgcn_mfma_f32_32x32x16_bf16(k1, qf[ks], ks == 0 ? pat1 : p1, 0, 0, 0);
                }
                const float mm = bnd + c * dl;
                float ls = 0.f;
                if (dbw - 63 >= 0 && dbw + 31 <= P.maxdist) {
#pragma unroll
                    for (int r = 0; r < 16; ++r) { p0[r] = fast_exp2(p0[r] - mm); p1[r] = fast_exp2(p1[r] - mm); ls += p0[r] + p1[r]; }
                } else {
#pragma unroll
                    for (int r = 0; r < 16; ++r) {
                        const float d0 = dl - (float)((r & 3) + 8 * (r >> 2)), d1 = d0 - 32.f;
                        const float e0 = fast_exp2(p0[r] - mm), e1 = fast_exp2(p1[r] - mm);
                        p0[r] = (d0 >= 0.f && d0 <= maxdf) ? e0 : 0.f; p1[r] = (d1 >= 0.f && d1 <= maxdf) ? e1 : 0.f; ls += p0[r] + p1[r];
                    }
                }
                l_run += ls;
            } else {
#pragma unroll
            for (int r = 0; r < 16; ++r) { p0[r] = 0.f; p1[r] = 0.f; }
#pragma unroll
            for (int ks = 0; ks < 4; ++ks) {
                const bf16x8 k0 = *(const LAS bf16x8*)(ka + ks * 32), k1 = *(const LAS bf16x8*)(ka + 32 * KP + ks * 32);
                p0 = __builtin_amdgcn_mfma_f32_32x32x16_bf16(k0, qf[ks], p0, 0, 0, 0);
                p1 = __builtin_amdgcn_mfma_f32_32x32x16_bf16(k1, qf[ks], p1, 0, 0, 0);
            }
            float mt = -INFINITY;
#pragma unroll
            for (int r = 0; r < 16; ++r) {
                const float d0 = dl - (float)((r & 3) + 8 * (r >> 2)), d1 = d0 - 32.f;
                float s0 = fmaf(-c, d0, p0[r]), s1 = fmaf(-c, d1, p1[r]);
                s0 = (d0 >= 0.f && d0 <= maxdf) ? s0 : -INFINITY; s1 = (d1 >= 0.f && d1 <= maxdf) ? s1 : -INFINITY;
                p0[r] = s0; p1[r] = s1; mt = fmaxf(mt, fmaxf(s0, s1));
            }
            mt = fmaxf(mt, shfl_xor_f(mt, 32));
            const float m_new = fmaxf(m_run, mt), m_use = (m_new == -INFINITY) ? 0.f : m_new;
            const float alpha = fast_exp2(m_run - m_use);
            m_run = m_new;
            float ls = 0.f;
#pragma unroll
            for (int r = 0; r < 16; ++r) { p0[r] = fast_exp2(p0[r] - m_use); p1[r] = fast_exp2(p1[r] - m_use); ls += p0[r] + p1[r]; }
            l_run = l_run * alpha + ls;
            if (!__all(alpha == 1.f)) {
#pragma unroll
                for (int db = 0; db < NDB; ++db)
#pragma unroll
                    for (int r = 0; r < 16; ++r) o[db][r] *= alpha;
            }
            }
            bf16x8 pk[4];
            pk[0] = pack8(p0[0], p0[1], p0[2], p0[3], p0[4], p0[5], p0[6], p0[7]); pk[1] = pack8(p0[8], p0[9], p0[10], p0[11], p0[12], p0[13], p0[14], p0[15]);
            pk[2] = pack8(p1[0], p1[1], p1[2], p1[3], p1[4], p1[5], p1[6], p1[7]); pk[3] = pack8(p1[8], p1[9], p1[10], p1[11], p1[12], p1[13], p1[14], p1[15]);
            const LAS unsigned char* va = Vt + (4 * hi + ((lane & 15) >> 2)) * VP + (16 * ((lane >> 4) & 1) + 4 * (lane & 3)) * 2;
            s16x4 vlo[2][NDB], vhi[2][NDB];
            const unsigned vaddr = (unsigned)(size_t)va;
#define ATT_TR(dst, off) asm volatile("ds_read_b64_tr_b16 %0, %1 offset:%c2" : "=&v"(dst) : "v"(vaddr), "i"(off) : "memory")
#pragma unroll
            for (int db = 0; db < NDB; ++db) { ATT_TR(vlo[0][db], db * 64); ATT_TR(vhi[0][db], 8 * VP + db * 64); }
#pragma unroll
            for (int s = 0; s < 4; ++s) {
                if (s < 3) {
#pragma unroll
                    for (int db = 0; db < NDB; ++db) { ATT_TR(vlo[(s + 1) & 1][db], (16 * (s + 1)) * VP + db * 64); ATT_TR(vhi[(s + 1) & 1][db], (16 * (s + 1) + 8) * VP + db * 64); }
                    if (NDB == 4) asm volatile("s_waitcnt lgkmcnt(8)" ::: "memory"); else asm volatile("s_waitcnt lgkmcnt(4)" ::: "memory");
                } else asm volatile("s_waitcnt lgkmcnt(0)" ::: "memory");
                __builtin_amdgcn_sched_barrier(0);
                __builtin_amdgcn_s_setprio(1);
#pragma unroll
                for (int db = 0; db < NDB; ++db) {
                    s16x4 lo = vlo[s & 1][db], hh = vhi[s & 1][db];
                    asm volatile("" : "+v"(lo), "+v"(hh));
                    const bf16x8 vf = (bf16x8){lo[0], lo[1], lo[2], lo[3], hh[0], hh[1], hh[2], hh[3]};
                    o[db] = __builtin_amdgcn_mfma_f32_32x32x16_bf16(vf, pk[s], o[db], 0, 0, 0);
                }
                __builtin_amdgcn_s_setprio(0);
                __builtin_amdgcn_sched_barrier(0);
            }
#undef ATT_TR
        }
        if (more) ATT_STORET(stg ^ 1);
        __syncthreads();
        stg ^= 1;
    }
#undef ATT_LOADT
#undef ATT_STORET
    const float l_tot = l_run + shfl_xor_f(l_run, 32);
    const float inv = 1.f / l_tot;
    if (!DIFF) {
        bf16* op = P.O + (size_t)(P.qrow0 + qidx * P.rs) * P.pitch + sidx * P.scol + 4 * hi;
#pragma unroll
        for (int db = 0; db < NDB; ++db)
#pragma unroll
            for (int rq = 0; rq < 4; ++rq) {
                const unsigned w0 = cvtpk(o[db][4 * rq] * inv, o[db][4 * rq + 1] * inv), w1 = cvtpk(o[db][4 * rq + 2] * inv, o[db][4 * rq + 3] * inv);
                *(unsigned long long*)(op + 32 * db + 8 * rq) = (unsigned long long)w0 | ((unsigned long long)w1 << 32);
            }
        if (hi == 0) P.lse[(size_t)(P.qrow0 + qidx * P.rs) * 12 + P.lsecol + sidx] = (FAST ? bnd : m_run) + log2f(l_tot);
    } else {
        LAS float* X = (LAS float*)lds;
        if (sidx == 1) {
            const float sc = P.lam * inv;
#pragma unroll
            for (int db = 0; db < NDB; ++db)
#pragma unroll
                for (int r = 0; r < 16; ++r) X[((w4 * 4 + db) * 16 + r) * 64 + lane] = o[db][r] * sc;
        }
        __syncthreads();
        if (sidx == 0) {
            float ss = 0.f;
#pragma unroll
            for (int db = 0; db < NDB; ++db)
#pragma unroll
                for (int r = 0; r < 16; ++r) { const float v = o[db][r] * inv - X[((w4 * 4 + db) * 16 + r) * 64 + lane]; o[db][r] = v; ss += v * v; }
            ss += shfl_xor_f(ss, 32);
            const float rr = rsqrtf(ss * (1.f / 128.f) + EPS) * P.onem;
            bf16* op = P.O + (size_t)(P.qrow0 + qidx) * P.pitch + 4 * hi;
            const float* gp = P.sub + 4 * hi;
#pragma unroll
            for (int db = 0; db < NDB; ++db)
#pragma unroll
                for (int rq = 0; rq < 4; ++rq) {
                    const f32x4 g = *(const f32x4*)(gp + 32 * db + 8 * rq);
                    const unsigned w0 = cvtpk(o[db][4 * rq] * rr * g[0], o[db][4 * rq + 1] * rr * g[1]), w1 = cvtpk(o[db][4 * rq + 2] * rr * g[2], o[db][4 * rq + 3] * rr * g[3]);
                    *(unsigned long long*)(op + 32 * db + 8 * rq) = (unsigned long long)w0 | ((unsigned long long)w1 << 32);
                }
        }
        __syncthreads();
    }
}
__device__ __forceinline__ float slope2(int head) { return exp2f(-0.5f * (float)(head + 1)) * LOG2E; }
__device__ __forceinline__ float qk_bound(const float* gq, const float* gk, int lane) {
    return 64.f * QSCALE * wave_max(fabsf(gq[lane])) * wave_max(fabsf(gk[lane])) * 1.02f + 0.25f;
}
__device__ __forceinline__ void diff_phase(LAS unsigned char* lds, unsigned char* ws, const float* sub, const float* bnds, float lam, float lam_init, int bx, int G, int wave, int lane, bf16* Oalt = nullptr) {
    for (int it = bx; it < 256; it += G) {
        const int b = it & 7, h = (it >> 6) & 3, p = (it >> 3) & 7;
        for (int half = 0; half < 2; ++half) {
            const int qb = half ? 15 - p : p;
            UnitP P;
            P.Q = (const bf16*)(ws + WS_QD) + h * 128; P.K = (const bf16*)(ws + WS_KD) + h * 128; P.V = (const bf16*)(ws + WS_VD) + h * 128; P.O = (Oalt ? Oalt : (bf16*)(ws + WS_QD)) + h * 128;
            P.pitch = 512; P.scol = 64; P.qrow0 = b * SEQ + qb * 128; P.krow0 = b * SEQ; P.rs = 1; P.t0 = 0; P.t1 = 2 * (qb + 1);
            P.D0 = qb * 128; P.maxdist = 1 << 20; P.c0 = P.c1 = slope2(12 + h); P.lam = lam; P.onem = 1.f - lam_init; P.sub = sub + h * 128; P.lse = nullptr; P.lsecol = 0;
            P.bnd0 = bnds[12 + 2 * h]; P.bnd1 = bnds[13 + 2 * h];
            if (P.bnd0 <= 40.f && P.bnd1 <= 40.f) attn_unit<true, true>(lds, P, wave, lane); else attn_unit<true, false>(lds, P, wave, lane);
        }
    }
}
__device__ __forceinline__ void dil_phase(LAS unsigned char* lds, unsigned char* ws, const float* bnds, int bx, int G, int wave, int lane, bf16* Oalt = nullptr) {
    for (int u = bx; u < 768; u += G) {
        int pair, g, r, n;
        const int b = u & 7, v = u >> 3;
        if (v < 54) { pair = v / 27; const int j = v % 27; if (j < 15) { g = 0; r = 0; n = j + 1; } else { g = 1; r = (j - 15) / 3; n = (j - 15) % 3 + 1; } }
        else { const int w = v - 54; pair = w / 21; const int j = w % 21; n = 0; if (j == 0) { g = 0; r = 0; } else if (j < 5) { g = 1; r = j - 1; } else { g = 2; r = j - 5; } }
        const int hg0 = pair * 2, dil = 1 << (2 * g), head = g * 4 + hg0;
        UnitP P;
        P.Q = (const bf16*)(ws + WS_QA) + head * 64; P.K = (const bf16*)(ws + WS_KA) + head * 64; P.V = (const bf16*)(ws + WS_VA) + head * 64; P.O = (Oalt ? Oalt : (bf16*)(ws + WS_QA)) + head * 64;
        P.pitch = 768; P.scol = 64; P.rs = dil; P.qrow0 = b * SEQ + r + n * 128 * dil; P.krow0 = b * SEQ + r + (n - 1) * 128 * dil;
        P.t0 = (n == 0) ? 2 : 0; P.t1 = 4; P.D0 = 128; P.maxdist = 128; P.c0 = slope2(head) * (float)dil; P.c1 = slope2(head + 1) * (float)dil;
        P.lam = 0.f; P.onem = 0.f; P.sub = nullptr; P.lse = (float*)(ws + WS_LSE); P.lsecol = head;
        P.bnd0 = bnds[head]; P.bnd1 = bnds[head + 1];
        if (P.bnd0 <= 40.f && P.bnd1 <= 40.f) attn_unit<false, true>(lds, P, wave, lane); else attn_unit<false, false>(lds, P, wave, lane);
    }
}
__device__ __forceinline__ void dil_combine(unsigned char* ws, int gw, int NGW, int lane_in) {
    const int lane = launder(lane_in);
    const bf16* OG = (const bf16*)(ws + WS_QA); const float* LSE = (const float*)(ws + WS_LSE); bf16* OD = (bf16*)(ws + WS_ODIL);
    for (int item = gw; item < M; item += NGW) {
        const int row = ((item >> 3) & 7) * SEQ + ((item >> 6) << 3) + (item & 7), hg = lane >> 4, c4 = (lane & 15) * 4;
        const float l0 = LSE[(size_t)row * 12 + hg], l1 = LSE[(size_t)row * 12 + 4 + hg], l2 = LSE[(size_t)row * 12 + 8 + hg];
        const float mx = fmaxf(l0, fmaxf(l1, l2)), e0 = exp2f(l0 - mx), e1 = exp2f(l1 - mx), e2 = exp2f(l2 - mx), is = 1.f / (e0 + e1 + e2);
        const float a0 = e0 * is, a1 = e1 * is, a2 = e2 * is;
        const unsigned long long w0 = *(const unsigned long long*)(OG + (size_t)row * 768 + hg * 64 + c4), w1 = *(const unsigned long long*)(OG + (size_t)row * 768 + 256 + hg * 64 + c4),
                                 w2 = *(const unsigned long long*)(OG + (size_t)row * 768 + 512 + hg * 64 + c4);
        float y[4];
#pragma unroll
        for (int e = 0; e < 4; ++e) y[e] = a0 * bf2f((unsigned short)(w0 >> (16 * e))) + a1 * bf2f((unsigned short)(w1 >> (16 * e))) + a2 * bf2f((unsigned short)(w2 >> (16 * e)));
        *(unsigned long long*)(OD + (size_t)row * 768 + hg * 64 + c4) = (unsigned long long)pk2(y[0], y[1]) | ((unsigned long long)pk2(y[2], y[3]) << 32);
    }
}
}

#define XB_TMO      128
#define XB_XCNT(j)  (256  + 64 * (j))
#define XB_XSUB(j)  (1280 + 64 * (j))
#define XB_XGEN(j)  (2304 + 64 * (j))
#define XB_TOP      3328
#define XB_TOPGEN   3392
#define XCD_BAR_WORDS 3456
#define XB_EXIT 3456
#define XB_SPIN_CAP (1u << 18)

__device__ __forceinline__ unsigned xb_ld(unsigned* p)              { return __hip_atomic_load(p, __ATOMIC_RELAXED, __HIP_MEMORY_SCOPE_AGENT); }
__device__ __forceinline__ unsigned xb_add(unsigned* p, unsigned v) { return __hip_atomic_fetch_add(p, v, __ATOMIC_RELAXED, __HIP_MEMORY_SCOPE_AGENT); }
__device__ __forceinline__ unsigned xb_xcc_id() { return (unsigned)__builtin_amdgcn_s_getreg((3 << 11) | 20) & 0xFu; }
#define XB_SPIN(cond, bar) do { unsigned _sp = 0; while (cond) { __builtin_amdgcn_s_sleep(1); \
    if ((++_sp & 255u) == 0u) { if (xb_ld(&(bar)[XB_TMO])) break; if (_sp > XB_SPIN_CAP) { atomicAdd(&(bar)[XB_TMO], 1u); break; } } } } while (0)

__device__ unsigned g_barwords[XCD_BAR_WORDS + 64];
struct XcdBarrier {
    unsigned* bar; unsigned x;
    volatile LAS unsigned* st;
};

__device__ __forceinline__ XcdBarrier xcd_barrier_post(unsigned* bar, volatile LAS unsigned* st, bool t0) {
    XcdBarrier b; b.bar = bar; b.x = xb_xcc_id(); b.st = st;
    if (t0) (void)xb_add(&bar[XB_XCNT(b.x)], 1u);
    return b;
}
__device__ __forceinline__ void xcd_barrier_complete(unsigned* bar, unsigned x, unsigned& nloc, unsigned& nx) {
    const unsigned G = gridDim.x * gridDim.y * gridDim.z;
    unsigned sum, cnt, mine, sp = 0u;
    for (;;) {
        sum = 0u; cnt = 0u; mine = 0u;
#pragma unroll
        for (unsigned j = 0; j < 16; ++j) { const unsigned c = xb_ld(&bar[XB_XCNT(j)]); sum += c; cnt += (c > 0u) ? 1u : 0u; mine = (j == x) ? c : mine; }
        if (sum == G) break;
        __builtin_amdgcn_s_sleep(1);
        if ((++sp & 255u) == 0u) { if (xb_ld(&bar[XB_TMO])) break; if (sp > XB_SPIN_CAP) { atomicAdd(&bar[XB_TMO], 1u); break; } }
    }
    nloc = mine > 0u ? mine : 1u; nx = cnt > 0u ? cnt : 1u;
}

__device__ __forceinline__ void xcd_barrier(const XcdBarrier& b, bool t0) {
    asm volatile("s_waitcnt vmcnt(0)" ::: "memory");
    __syncthreads();
    if (t0) {
        unsigned* bar = b.bar;
        __builtin_amdgcn_s_waitcnt(0);
        unsigned nloc = b.st[0], nx = b.st[1];
        if (nloc == 0u) { xcd_barrier_complete(bar, b.x, nloc, nx); b.st[0] = nloc; b.st[1] = nx; }
        const unsigned old = xb_add(&bar[XB_XSUB(b.x)], 1u);
        const unsigned gen = old / nloc;
        if (old + 1u == (gen + 1u) * nloc) {
            __builtin_amdgcn_fence(__ATOMIC_RELEASE, "agent");
            asm volatile("s_waitcnt vmcnt(0)" ::: "memory");
            const unsigned og = xb_add(&bar[XB_TOP], 1u);
            const unsigned tg = og / nx;
            if (og + 1u == (tg + 1u) * nx) xb_add(&bar[XB_TOPGEN], 1u);
            else XB_SPIN(xb_ld(&bar[XB_TOPGEN]) == tg, bar);
            __builtin_amdgcn_fence(__ATOMIC_ACQUIRE, "agent");
            xb_add(&bar[XB_XGEN(b.x)], 1u);
            asm volatile("s_waitcnt vmcnt(0)" ::: "memory");
        } else {
            XB_SPIN(xb_ld(&bar[XB_XGEN(b.x)]) == gen, bar);
            __builtin_amdgcn_fence(__ATOMIC_ACQUIRE, "agent");
            asm volatile("s_waitcnt vmcnt(0)" ::: "memory");
        }
    }
    __syncthreads();
}

#define XB_FLAG 192
__device__ __forceinline__ void xcc_local_barrier(unsigned* bar, unsigned x, unsigned nloc, bool t0) {
    asm volatile("s_waitcnt vmcnt(0)" ::: "memory");
    __syncthreads();
    if (t0) {
        __builtin_amdgcn_s_waitcnt(0);
        const unsigned old = xb_add(&bar[XB_XSUB(x)], 1u), gen = old / nloc;
        if (old + 1u == (gen + 1u) * nloc) xb_add(&bar[XB_XGEN(x)], 1u);
        else XB_SPIN(xb_ld(&bar[XB_XGEN(x)]) == gen, bar);
        __builtin_amdgcn_fence(__ATOMIC_ACQUIRE, "agent");
        asm volatile("s_waitcnt vmcnt(0)" ::: "memory");
    }
    __syncthreads();
}
struct Args {
    const float* x; const float* ffn1_norm; const float* ffn1_w_in; const float* ffn1_w_out; const float* mix_norm; const float* w_in;
    const float* qk_gain_dil; const float* qk_gain_diff; const float* lambda_q; const float* lambda_k; const float* diff_subnorm;
    const float* w_branch_dil; const float* w_branch_diff; const float* w_out; const float* ffn2_norm; const float* ffn2_w_in; const float* ffn2_w_out;
    float* out; unsigned char* ws;
};
constexpr int LDS_BYTES = 147456;

__device__ __forceinline__ const float* ldptr(LAS unsigned long long* ptab, int i) {
    const unsigned long long v = ptab[i];
    const unsigned lo = __builtin_amdgcn_readfirstlane((unsigned)v), hi = __builtin_amdgcn_readfirstlane((unsigned)(v >> 32));
    return (const float*)(((unsigned long long)hi << 32) | lo);
}
constexpr int PTAB_OFF = LDS_BYTES - 256;
enum { I_X = 0, I_F1N, I_F1I, I_F1O, I_MN, I_WIN, I_GDIL, I_GDIFF, I_LQ, I_LK, I_SUB, I_WA, I_WB, I_WO, I_F2N, I_F2I, I_F2O, I_OUT, I_WS };
__global__ void __launch_bounds__(512, 2) fwd_kernel(Args a) {
    extern __shared__ __attribute__((aligned(16))) unsigned char lds_raw[];
    cg::grid_group grid = cg::this_grid();
    LAS unsigned char* lds = (LAS unsigned char*)lds_raw;
    if (threadIdx.x == 0) {
        LAS unsigned long long* ptab = (LAS unsigned long long*)(lds + PTAB_OFF);
        ptab[I_X] = (unsigned long long)a.x; ptab[I_F1N] = (unsigned long long)a.ffn1_norm; ptab[I_F1I] = (unsigned long long)a.ffn1_w_in; ptab[I_F1O] = (unsigned long long)a.ffn1_w_out;
        ptab[I_MN] = (unsigned long long)a.mix_norm; ptab[I_WIN] = (unsigned long long)a.w_in; ptab[I_GDIL] = (unsigned long long)a.qk_gain_dil; ptab[I_GDIFF] = (unsigned long long)a.qk_gain_diff;
        ptab[I_LQ] = (unsigned long long)a.lambda_q; ptab[I_LK] = (unsigned long long)a.lambda_k; ptab[I_SUB] = (unsigned long long)a.diff_subnorm; ptab[I_WA] = (unsigned long long)a.w_branch_dil;
        ptab[I_WB] = (unsigned long long)a.w_branch_diff; ptab[I_WO] = (unsigned long long)a.w_out; ptab[I_F2N] = (unsigned long long)a.ffn2_norm; ptab[I_F2I] = (unsigned long long)a.ffn2_w_in;
        ptab[I_F2O] = (unsigned long long)a.ffn2_w_out; ptab[I_OUT] = (unsigned long long)a.out; ptab[I_WS] = (unsigned long long)a.ws;
    }
    const int wave0 = __builtin_amdgcn_readfirstlane(threadIdx.x >> 6);
    if (threadIdx.x < 3) ((volatile LAS unsigned*)(lds + PTAB_OFF + 192))[threadIdx.x] = 0u;
    __syncthreads();
    if (a.ws == nullptr) grid.sync();
    (void)xcd_barrier_post(g_barwords, (volatile LAS unsigned*)(lds + PTAB_OFF + 192), threadIdx.x == 0);
    if (threadIdx.x == 0 && (xb_xcc_id() != (blockIdx.x & 7u) || gridDim.x != 256u)) (void)xb_add(g_barwords + XB_FLAG, 1u);
#define GRID_SYNC() do { XcdBarrier b_; b_.bar = g_barwords; b_.x = xb_xcc_id(); b_.st = (volatile LAS unsigned*)(lds + PTAB_OFF + 192 + launder(0)); xcd_barrier(b_, wave == 0 && lane_id() == 0); } while (0)
#define GRID_SYNC_L() do { volatile LAS unsigned* st_ = (volatile LAS unsigned*)(lds + PTAB_OFF + 192 + launder(0)); \
        if (__builtin_amdgcn_readfirstlane((int)st_[2])) { \
            xcc_local_barrier(g_barwords, xb_xcc_id(), (unsigned)__builtin_amdgcn_readfirstlane((int)st_[0]), wave == 0 && lane_id() == 0); \
        } else GRID_SYNC(); } while (0)

    {
        int wave = wave0; asm volatile("" : "+s"(wave));
        const int G = gridDim.x, bx = blockIdx.x, gw = bx * 8 + wave, NGW = G * 8;
        LAS unsigned long long* ptab = (LAS unsigned long long*)(lds + PTAB_OFF + launder(0));
        unsigned char* ws = (unsigned char*)ldptr(ptab, I_WS);
        LAS float* scr = (LAS float*)(lds + wave * 16384);
        float* SS = (float*)(ws + WS_SS);
        { const int ln = lane_id(); if (bx == 0 && wave == 0 && ln < 8) ((unsigned*)(ws + WS_CTR))[ln * 64] = 0u; }
        convert_weight<1>(ldptr(ptab, I_F1I), ldptr(ptab, I_F1N), DM, 2 * FF, 2 * FF, (bf16*)(ws + WS_WFI), scr, gw, NGW, lane_id());
        convert_weight<0>(ldptr(ptab, I_F1O), nullptr, FF, DM, DM, (bf16*)(ws + WS_WFO), scr, gw, NGW, lane_id());
        if (gw < 40) {
            const int l = gw / 20, j = gw % 20, ln = lane_id();
            const float* gq; const float* gk;
            if (j < 12) { gq = ldptr(ptab, I_GDIL) + (size_t)l * 1536 + j * 64; gk = gq + 768; }
            else { gq = ldptr(ptab, I_GDIFF) + (size_t)l * 1024 + (j - 12) * 64; gk = gq + 512; }
            const float b = att::qk_bound(gq, gk, ln);
            if (ln == 0) ((float*)(ws + WS_BND))[gw] = b;
        }
        prologue_rows(ldptr(ptab, I_X), (bf16*)(ws + WS_XN), SS, gw, NGW, lane_id());
        GRID_SYNC();
        if (wave == 0 && lane_id() == 0) ((volatile LAS unsigned*)(lds + PTAB_OFF + 192))[2] = (xb_ld(g_barwords + XB_FLAG) == 0u) ? 1u : 0u;
        __syncthreads();
    }
    for (int st = 0; st < 6; ++st) {
        const int l = st / 3, s = st % 3;
        int wave = wave0; asm volatile("" : "+s"(wave));
        const int G = gridDim.x, bx = blockIdx.x, gw = bx * 8 + wave, NGW = G * 8;
        LAS unsigned long long* ptab = (LAS unsigned long long*)(lds + PTAB_OFF + launder(0));
        unsigned char* ws = (unsigned char*)ldptr(ptab, I_WS);
        float* out = (float*)ldptr(ptab, I_OUT);
        bf16* XN = (bf16*)(ws + WS_XN); bf16* Hb = (bf16*)(ws + WS_H);
        const float* SScur = (const float*)(ws + WS_SS) + (size_t)(st & 1) * M * 16; float* SSnext = (float*)(ws + WS_SS) + (size_t)((st + 1) & 1) * M * 16;
        unsigned* ctrs = (unsigned*)(ws + WS_CTR);
        LAS float* scr = (LAS float*)(lds + wave * 16384);
        if (s != 1) {
            const bool alt = (s == 0 && l == 1);
            const bf16* WFIu = (const bf16*)(ws + (alt ? WS_WFI_ALT : WS_WFI)); const bf16* WFOu = (const bf16*)(ws + (alt ? WS_WFO_ALT : WS_WFO));
            { pg8::Gemm g{XN, WFIu, M, 2 * FF, DM}; pg8::StaticOrder S; S.init(M, 2 * FF, G, bx); EpiSwiGLU E{Hb, SScur};
              pg8::gemm_phase<EpiSwiGLU, pg8::StaticOrder, true, true>(lds, g, S, E, wave); }
            if (s == 0)
                mixer_jobs(ctrs + 64 * (l == 0 ? 0 : 3), ldptr(ptab, I_WIN) + (size_t)l * DM * NPROJ, ldptr(ptab, I_MN) + (size_t)l * DM, ldptr(ptab, I_WA) + (size_t)l * 256 * DM,
                           ldptr(ptab, I_WB) + (size_t)l * 512 * DM, ldptr(ptab, I_WO) + (size_t)l * DM * DM, ws, scr, lane_id());
            else if (l == 0)
                ffn_jobs(ctrs + 64 * 2, ldptr(ptab, I_F1I) + (size_t)DM * 2 * FF, ldptr(ptab, I_F1N) + DM, ldptr(ptab, I_F1O) + (size_t)FF * DM, (bf16*)(ws + WS_WFI_ALT), (bf16*)(ws + WS_WFO_ALT), scr, lane_id());
            GRID_SYNC_L();
            { pg8::Gemm g{Hb, WFOu, M, DM, FF}; pg8::StaticOrder S; S.init(M, DM, G, bx); EpiResid E{out, XN, SSnext, 0.5f, st == 5 ? 1 : 0};
              pg8::gemm_phase<EpiResid, pg8::StaticOrder, true, true>(lds, g, S, E, wave); }
            if (st != 5) GRID_SYNC();
        } else {
            { pg8::Gemm g{XN, (const bf16*)(ws + WS_WPR), M, NPROJ, DM}; pg8::StaticOrder S; S.init(M, NPROJ, G, bx);
              EpiProj E{ws, ldptr(ptab, I_GDIL) + (size_t)l * 1536, ldptr(ptab, I_GDIFF) + (size_t)l * 1024, SScur};
              pg8::gemm_phase<EpiProj, pg8::StaticOrder, true, true>(lds, g, S, E, wave); }
            ffn_jobs(ctrs + 64 * (l == 0 ? 1 : 4), ldptr(ptab, I_F2I) + (size_t)l * DM * 2 * FF, ldptr(ptab, I_F2N) + (size_t)l * DM, ldptr(ptab, I_F2O) + (size_t)l * FF * DM, (bf16*)(ws + WS_WFI), (bf16*)(ws + WS_WFO), scr, lane_id());
            GRID_SYNC_L();
            {
                const float lam_init = 0.8f - 0.6f * expf(-0.3f * (float)l);
                const float* lq = ldptr(ptab, I_LQ) + l * 128; const float* lk = ldptr(ptab, I_LK) + l * 128;
                const int ln = lane_id();
                const float d0 = wave_sum(lq[ln] * lk[ln]), d1 = wave_sum(lq[64 + ln] * lk[64 + ln]);
                const float lam = expf(d0) - expf(d1) + lam_init;
                att::diff_phase(lds, ws, ldptr(ptab, I_SUB) + l * 512, (const float*)(ws + WS_BND) + l * 20, lam, lam_init, bx, G, wave, lane_id());
                att::dil_phase(lds, ws, (const float*)(ws + WS_BND) + l * 20, bx, G, wave, lane_id());
                GRID_SYNC_L();
                att::dil_combine(ws, gw, NGW, lane_id());
            }
            GRID_SYNC_L();
            {
            { pg8::Gemm g{(const bf16*)(ws + WS_ODIL), (const bf16*)(ws + WS_WA), M, DM, 256, 768}; pg8::StaticOrder S; S.init(M, DM, G, bx); EpiMerge<1> E{(bf16*)(ws + WS_Y), (const bf16*)(ws + WS_GA)};
              pg8::gemm_phase<EpiMerge<1>, pg8::StaticOrder, true, true>(lds, g, S, E, wave); }
            { pg8::Gemm g{(const bf16*)(ws + WS_QD), (const bf16*)(ws + WS_WB), M, DM, 512}; pg8::StaticOrder S; S.init(M, DM, G, bx); EpiMerge<2> E{(bf16*)(ws + WS_Y), (const bf16*)(ws + WS_GB)};
              pg8::gemm_phase<EpiMerge<2>, pg8::StaticOrder, true, true>(lds, g, S, E, wave); }
            }
            GRID_SYNC_L();
            { pg8::Gemm g{(const bf16*)(ws + WS_Y), (const bf16*)(ws + WS_WO), M, DM, DM}; pg8::StaticOrder S; S.init(M, DM, G, bx); EpiResid E{out, XN, SSnext, 1.0f, 0};
              pg8::gemm_phase<EpiResid, pg8::StaticOrder, true, true>(lds, g, S, E, wave); }
            GRID_SYNC();
        }
    }
    {
        int wave = wave0; asm volatile("" : "+s"(wave));
        volatile LAS unsigned* ex = (volatile LAS unsigned*)(lds + PTAB_OFF + 192 + launder(0));
        const unsigned ln = (unsigned)lane_id();
        if (wave == 0 && ln == 0u) ex[3] = (xb_add(&g_barwords[XB_EXIT], 1u) == gridDim.x - 1u) ? 1u : 0u;
        __syncthreads();
        if (ex[3]) for (unsigned i = (unsigned)wave * 64u + ln; i < XCD_BAR_WORDS + 64u; i += 512u) __hip_atomic_store(&g_barwords[i], 0u, __ATOMIC_RELAXED, __HIP_MEMORY_SCOPE_AGENT);
    }
}

extern "C" void kernel_launch(void* const* d_in, const int* in_sizes, int n_in, void* d_out, int out_size, void* d_ws, size_t ws_size, hipStream_t stream) {
    static int grid = 0;
    if (grid == 0) {
        if (n_in != 17 || out_size != M * DM || ws_size < WS_SS + 2 * MiB) { fprintf(stderr, "kernel_launch: unexpected shapes (n_in %d out %d ws %zu)\n", n_in, out_size, ws_size); grid = -1; return; }
        int dev = 0, cus = 0, per_cu = 0;
        hipGetDevice(&dev); hipDeviceGetAttribute(&cus, hipDeviceAttributeMultiprocessorCount, dev);
        hipFuncSetAttribute((const void*)fwd_kernel, hipFuncAttributeMaxDynamicSharedMemorySize, LDS_BYTES);
        hipOccupancyMaxActiveBlocksPerMultiprocessor(&per_cu, (const void*)fwd_kernel, 512, LDS_BYTES);
        if (per_cu < 1) { fprintf(stderr, "kernel_launch: occupancy query says %d blocks/CU\n", per_cu); per_cu = 1; }
        (void)hipGetLastError();
        grid = cus;
    }
    if (grid < 0) return;
    Args a{};
    a.x = (const float*)d_in[0]; a.ffn1_norm = (const float*)d_in[1]; a.ffn1_w_in = (const float*)d_in[2]; a.ffn1_w_out = (const float*)d_in[3];
    a.mix_norm = (const float*)d_in[4]; a.w_in = (const float*)d_in[5]; a.qk_gain_dil = (const float*)d_in[6]; a.qk_gain_diff = (const float*)d_in[7];
    a.lambda_q = (const float*)d_in[8]; a.lambda_k = (const float*)d_in[9]; a.diff_subnorm = (const float*)d_in[10]; a.w_branch_dil = (const float*)d_in[11];
    a.w_branch_diff = (const float*)d_in[12]; a.w_out = (const float*)d_in[13]; a.ffn2_norm = (const float*)d_in[14]; a.ffn2_w_in = (const float*)d_in[15]; a.ffn2_w_out = (const float*)d_in[16];
    a.out = (float*)d_out; a.ws = (unsigned char*)d_ws;
    void* args[] = {&a};
    hipError_t e = hipLaunchCooperativeKernel((const void*)fwd_kernel, dim3(grid), dim3(512), args, LDS_BYTES, stream);
    if (e != hipSuccess) fprintf(stderr, "kernel_launch: cooperative launch failed: %s (grid %d)\n", hipGetErrorString(e), grid);
}
```

```cpp
#include <hip/hip_runtime.h>
#include <hip/hip_cooperative_groups.h>
#include <cstdio>
#include <cstdint>
namespace cg = cooperative_groups;
namespace pg8 {
#define PG8_LAS __attribute__((address_space(3)))
typedef unsigned short bf16_t;
typedef short bf16x8 __attribute__((ext_vector_type(8)));
typedef float f32x4 __attribute__((ext_vector_type(4)));
typedef unsigned u32x4 __attribute__((ext_vector_type(4)));
constexpr int BM = 256, BK = 64, HALF = 128, HTB = HALF * BK * 2  , STAGE_BYTES = 8 * HTB, NXCD = 8, WGM = 8;

__host__ __device__ __forceinline__ int lds_byte(int r, int c) { const int st = (r >> 4) * 2 + (c >> 5), rr = r & 15, cc = c & 31, ob = rr * 64 + cc * 2; return st * 1024 + (ob ^ (((ob >> 9) & 1) << 5)); }
__host__ __device__ __forceinline__ void stage_rc(int b, int& R, int& C) { const int st = b / 1024, sb = b % 1024, swz = sb ^ (((sb >> 9) & 1) << 5); R = (st >> 1) * 16 + swz / 64; C = (st & 1) * 32 + (swz % 64) / 2; }
__host__ __device__ __forceinline__ int perm32(int rho) { const int n = rho >> 4, i = rho & 15; return 8 * (i >> 2) + 4 * n + (i & 3); }

struct Unit { int pm, pn; };
struct Gemm { const bf16_t* A; const bf16_t* Bt; int M, N, K; int lda; };

struct StaticOrder {
    int nM, nN, nwg, G, c;
    __host__ __device__ void init(int M, int N, int G_, int c_) { nM = M / BM; nN = N / BM; nwg = nM * nN; G = G_; c = c_; }
    __host__ __device__ bool next(int i, Unit& u) const {
        const long L = (long)i * G + c; if (L >= nwg) return false;
        int wgid = (int)L; { const int q = nwg / NXCD, r = nwg % NXCD, xcd = wgid % NXCD, off = wgid / NXCD; wgid = (xcd < r ? xcd * (q + 1) : r * (q + 1) + (xcd - r) * q) + off; }
        const int nig = WGM * nN, gid = wgid / nig, fm = gid * WGM, gsz = (nM - fm) < WGM ? (nM - fm) : WGM;
        u.pm = fm + ((wgid % nig) % gsz); u.pn = (wgid % nig) / gsz; return true;
    }
    __device__ __forceinline__ void a_ready(const Unit&) const {}
    __device__ __forceinline__ void done(const Unit&) const {}
};
__device__ __forceinline__ unsigned cvt_pk_bf16(float lo, float hi) { unsigned r; asm volatile("v_cvt_pk_bf16_f32 %0, %1, %2" : "=v"(r) : "v"(lo), "v"(hi)); return r; }
typedef float f32x2 __attribute__((ext_vector_type(2)));
template <class Epi, class Sched, bool ALIGN_EPI = false, bool SP2 = false>
__device__ __forceinline__ void gemm_phase(PG8_LAS unsigned char* lds, const Gemm g, const Sched& S, const Epi& E, const int wid_in) {
    int tid_; asm volatile("v_mbcnt_lo_u32_b32 %0, -1, 0\n\tv_mbcnt_hi_u32_b32 %0, -1, %0" : "=v"(tid_)); int wid_ = wid_in; asm volatile("" : "+s"(wid_)); tid_ += 64 * wid_; const int tid = tid_, wid = wid_, lane = tid & 63, wr = wid >> 2, wc = wid & 3, fr = lane & 15, fq = lane >> 4;
    const int K = g.K, nt = K / BK;
    unsigned voffA[2], voffB[2];
#pragma unroll
    for (int i = 0; i < 2; ++i) { int R, C; stage_rc(tid * 16 + i * 8192, R, C); const int Rb = Epi::PERM ? ((R & ~31) + perm32(R & 31)) : R;
        voffA[i] = (unsigned)(R * (g.lda ? g.lda : K) + C) * 2u; voffB[i] = (unsigned)(Rb * K + C) * 2u; }
    const size_t kstep = (size_t)(BK * 2);
    const size_t hstep = (size_t)HALF * K * 2;
    const size_t tstep = 2 * hstep;
    const int lda = g.lda ? g.lda : K;
    const size_t hstepA = (size_t)HALF * lda * 2, tstepA = 2 * hstepA;
    const unsigned ldsw = (unsigned)wid * 1024u;
    const int aoff = lds_byte(wr * 64 + fr, fq * 8), boff = lds_byte(wc * 32 + fr, fq * 8);
#define PG8_SA(b, h) (((b) * 2 + (h)) * HTB)
#define PG8_SB(b, h) ((4 + (b) * 2 + (h)) * HTB)
#define PG8_STAGE(bufoff, gbase, voff) do { _Pragma("unroll") for (int _i = 0; _i < 2; ++_i) \
        __builtin_amdgcn_global_load_lds((const unsigned*)((const char*)(gbase) + (voff)[_i]), (PG8_LAS unsigned*)(lds + (bufoff) + ldsw + _i * 8192), 16, 0, 0); } while (0)
#define PG8_LDA(dst, b, h) do { _Pragma("unroll") for (int m = 0; m < 4; ++m) _Pragma("unroll") for (int k = 0; k < 2; ++k) dst[m][k] = *(const PG8_LAS bf16x8*)(lds + PG8_SA(b, h) + aoff + m * 2048 + k * 1024); } while (0)
#define PG8_LDB(dst, b, h) do { _Pragma("unroll") for (int n = 0; n < 2; ++n) _Pragma("unroll") for (int k = 0; k < 2; ++k) dst[n][k] = *(const PG8_LAS bf16x8*)(lds + PG8_SB(b, h) + boff + n * 2048 + k * 1024); } while (0)
#define PG8_MMA(ai, bj, At, Bt) do { __builtin_amdgcn_s_setprio(1); _Pragma("unroll") for (int m = 0; m < 4; ++m) _Pragma("unroll") for (int n = 0; n < 2; ++n) _Pragma("unroll") for (int k = 0; k < 2; ++k) \
        acc[ai][bj][m][n] = __builtin_amdgcn_mfma_f32_16x16x32_bf16(Bt[n][k], At[m][k], acc[ai][bj][m][n], 0, 0, 0); __builtin_amdgcn_s_setprio(0); } while (0)
#define PG8_WAIT_V(n) asm volatile("s_waitcnt vmcnt(" #n ")" ::: "memory")
#define PG8_WAIT_L(n) asm volatile("s_waitcnt lgkmcnt(" #n ")" ::: "memory")
#define PG8_BAR __builtin_amdgcn_s_barrier()
#define PG8_SCHED __builtin_amdgcn_sched_barrier(0)
    Unit cur, nxt; int ui = 0;
    if (!S.next(0, cur)) return;
    f32x4 acc[2][2][4][2];
#pragma unroll
    for (int a = 0; a < 2; ++a)
#pragma unroll
        for (int b = 0; b < 2; ++b)
#pragma unroll
            for (int m = 0; m < 4; ++m)
#pragma unroll
                for (int n = 0; n < 2; ++n) acc[a][b][m][n] = (f32x4){0.f, 0.f, 0.f, 0.f};
    bf16x8 At[4][2], B0[2][2], B1[2][2];
    const char* cA = (const char*)g.A + (size_t)cur.pm * tstepA; const char* cB = (const char*)g.Bt + (size_t)cur.pn * tstep;
    S.a_ready(cur);
    if constexpr (SP2) {
        PG8_STAGE(PG8_SB(0, 0), cB, voffB); PG8_STAGE(PG8_SB(0, 1), cB + hstep, voffB); PG8_STAGE(PG8_SA(0, 0), cA, voffA); PG8_STAGE(PG8_SA(0, 1), cA + hstepA, voffA);
        if (wr == 1) PG8_BAR;
        PG8_WAIT_V(2); PG8_BAR;
        PG8_STAGE(PG8_SB(1, 0), cB + kstep, voffB); PG8_STAGE(PG8_SA(1, 0), cA + kstep, voffA); PG8_STAGE(PG8_SB(1, 1), cB + hstep + kstep, voffB);
        PG8_WAIT_V(6); PG8_BAR;
    } else {
        PG8_STAGE(PG8_SB(0, 0), cB, voffB); PG8_STAGE(PG8_SA(0, 0), cA, voffA); PG8_STAGE(PG8_SB(0, 1), cB + hstep, voffB); PG8_STAGE(PG8_SA(0, 1), cA + hstepA, voffA);
        if (wr == 1) PG8_BAR;
        PG8_WAIT_V(4); PG8_BAR;
        PG8_STAGE(PG8_SB(1, 0), cB + kstep, voffB); PG8_STAGE(PG8_SA(1, 0), cA + kstep, voffA); PG8_STAGE(PG8_SB(1, 1), cB + hstep + kstep, voffB);
        PG8_WAIT_V(6); PG8_BAR;
    }
    for (;;) {
        const bool has_next = S.next(ui + 1, nxt);
        const char* nA = has_next ? (const char*)g.A + (size_t)nxt.pm * tstepA : cA; const char* nB = has_next ? (const char*)g.Bt + (size_t)nxt.pn * tstep : cB;
        for (int t = 0; t < nt; t += 2) {
            const bool last = (t == nt - 2);
            const char* a1 = cA + (size_t)(t + 1) * kstep;
            const char* a2 = last ? nA : cA + (size_t)(t + 2) * kstep; const char* b2 = last ? nB : cB + (size_t)(t + 2) * kstep;
            const char* a3 = a2 + kstep; const char* b3 = b2 + kstep;
            if (last && has_next) S.a_ready(nxt);
            if constexpr (SP2) {
            PG8_LDB(B0, 0, 0); PG8_LDB(B1, 0, 1); PG8_SCHED; PG8_LDA(At, 0, 0); PG8_STAGE(PG8_SA(1, 1), a1 + hstepA, voffA);
            PG8_WAIT_V(8); PG8_WAIT_L(0); PG8_BAR; PG8_MMA(0, 0, At, B0); PG8_MMA(0, 1, At, B1); PG8_BAR; PG8_SCHED;
            PG8_LDA(At, 0, 1); PG8_STAGE(PG8_SB(0, 0), b2, voffB); PG8_STAGE(PG8_SB(0, 1), b2 + hstep, voffB); PG8_STAGE(PG8_SA(0, 0), a2, voffA);
            PG8_WAIT_V(8); PG8_WAIT_L(0); PG8_BAR; PG8_MMA(1, 0, At, B0); PG8_MMA(1, 1, At, B1); PG8_BAR; PG8_SCHED;
            PG8_LDB(B0, 1, 0); PG8_LDB(B1, 1, 1); PG8_SCHED; PG8_LDA(At, 1, 0); PG8_STAGE(PG8_SA(0, 1), a2 + hstepA, voffA);
            PG8_WAIT_V(8); PG8_WAIT_L(0); PG8_BAR; PG8_MMA(0, 0, At, B0); PG8_MMA(0, 1, At, B1); PG8_BAR; PG8_SCHED;
            PG8_LDA(At, 1, 1); PG8_STAGE(PG8_SB(1, 0), b3, voffB); PG8_STAGE(PG8_SB(1, 1), b3 + hstep, voffB); PG8_STAGE(PG8_SA(1, 0), a3, voffA);
            PG8_WAIT_V(8); PG8_WAIT_L(0); PG8_BAR; PG8_MMA(1, 0, At, B0); PG8_MMA(1, 1, At, B1); PG8_BAR; PG8_SCHED;
            } else {
            PG8_LDB(B0, 0, 0); PG8_SCHED; PG8_LDA(At, 0, 0); PG8_STAGE(PG8_SA(1, 1), a1 + hstepA, voffA);
            PG8_WAIT_L(8); PG8_BAR; PG8_WAIT_L(0); PG8_MMA(0, 0, At, B0); PG8_BAR; PG8_SCHED;
            PG8_LDB(B1, 0, 1); PG8_STAGE(PG8_SB(0, 0), b2, voffB);
            PG8_BAR; PG8_WAIT_L(0); PG8_MMA(0, 1, At, B1); PG8_BAR;
            PG8_LDA(At, 0, 1); PG8_STAGE(PG8_SA(0, 0), a2, voffA);
            PG8_BAR; PG8_WAIT_L(0); PG8_MMA(1, 0, At, B0); PG8_BAR; PG8_SCHED;
            PG8_STAGE(PG8_SB(0, 1), b2 + hstep, voffB);
            PG8_WAIT_V(6); PG8_BAR; PG8_MMA(1, 1, At, B1); PG8_BAR;
            PG8_LDB(B0, 1, 0); PG8_SCHED; PG8_LDA(At, 1, 0); PG8_STAGE(PG8_SA(0, 1), a2 + hstepA, voffA);
            PG8_WAIT_L(8); PG8_BAR; PG8_WAIT_L(0); PG8_MMA(0, 0, At, B0); PG8_BAR; PG8_SCHED;
            PG8_LDB(B1, 1, 1); PG8_STAGE(PG8_SB(1, 0), b3, voffB);
            PG8_BAR; PG8_WAIT_L(0); PG8_MMA(0, 1, At, B1); PG8_BAR;
            PG8_LDA(At, 1, 1); PG8_STAGE(PG8_SA(1, 0), a3, voffA);
            PG8_BAR; PG8_WAIT_L(0); PG8_MMA(1, 0, At, B0); PG8_BAR; PG8_SCHED;
            PG8_STAGE(PG8_SB(1, 1), b3 + hstep, voffB);
            PG8_WAIT_V(6); PG8_BAR; PG8_MMA(1, 1, At, B1); PG8_BAR;
            }
        }
        if constexpr (ALIGN_EPI) { if (wr == 0) PG8_BAR; }
        if constexpr (!Epi::AFTER_DRAIN) { int l2_; asm volatile("v_mbcnt_lo_u32_b32 %0, -1, 0\n\tv_mbcnt_hi_u32_b32 %0, -1, %0" : "=v"(l2_)); const int fr_ = l2_ & 15, fq_ = l2_ >> 4; E(acc, cur, wr, wc, fr_, fq_); S.done(cur); }
        if (!has_next) break;
#pragma unroll
        for (int a = 0; a < 2; ++a)
#pragma unroll
            for (int b = 0; b < 2; ++b)
#pragma unroll
                for (int m = 0; m < 4; ++m)
#pragma unroll
                    for (int n = 0; n < 2; ++n) acc[a][b][m][n] = (f32x4){0.f, 0.f, 0.f, 0.f};
        cur = nxt; cA = nA; cB = nB; ++ui;
        if constexpr (ALIGN_EPI) { if (wr == 1) PG8_BAR; }
    }
    PG8_WAIT_V(0);
    if constexpr (!ALIGN_EPI) { if (wr == 0) PG8_BAR; }
    PG8_BAR;
    if constexpr (Epi::AFTER_DRAIN) { E.fused(acc, cur, wr, wc, fr, fq, lds, wid, lane); S.done(cur); }
#undef PG8_SA
#undef PG8_SB
#undef PG8_STAGE
#undef PG8_LDA
#undef PG8_LDB
#undef PG8_MMA
#undef PG8_WAIT_V
#undef PG8_WAIT_L
#undef PG8_BAR
#undef PG8_SCHED
}
}

constexpr int M = 16384, DM = 1024, FF = 2816, SEQ = 2048, NPROJ = 5888;
constexpr float EPS = 1e-6f, LOG2E = 1.4426950408889634f;
constexpr float QSCALE = 0.125f * LOG2E;
#define LAS __attribute__((address_space(3)))
typedef unsigned short bf16;
typedef unsigned v4u __attribute__((ext_vector_type(4)));
using pg8::f32x4;

constexpr size_t MiB = 1u << 20;
constexpr size_t WS_LSE = 0;
constexpr size_t WS_SS = 251 * MiB;
constexpr size_t WS_CTR = 1 * MiB + 512 * 1024;
constexpr size_t WS_BND = 1 * MiB + 640 * 1024;
constexpr size_t WS_BAR = 1 * MiB + 768 * 1024;
constexpr size_t WS_WFI = 2 * MiB;
constexpr size_t WS_WFO = 13 * MiB;
constexpr size_t WS_WPR = 19 * MiB;
constexpr size_t WS_WA = 31 * MiB;
constexpr size_t WS_WB = 31 * MiB + 512 * 1024;
constexpr size_t WS_WO = 33 * MiB;
constexpr size_t WS_XN = 35 * MiB;
constexpr size_t WS_P = 67 * MiB;
constexpr size_t WS_QA = WS_P, WS_KA = WS_QA + 24 * MiB, WS_VA = WS_KA + 24 * MiB;
constexpr size_t WS_QD = WS_VA + 24 * MiB, WS_KD = WS_QD + 16 * MiB, WS_VD = WS_KD + 16 * MiB;
constexpr size_t WS_GA = WS_VD + 16 * MiB, WS_GB = WS_GA + 32 * MiB;
constexpr size_t WS_H = WS_P;
constexpr size_t WS_ODIL = WS_QA;
constexpr size_t WS_Y = WS_GA;
constexpr size_t WS_WFI_ALT = 156 * MiB, WS_WFO_ALT = 168 * MiB;
constexpr size_t WS_END = WS_GB + 32 * MiB;
static_assert(WS_END == 251 * MiB && WS_SS + 2 * MiB <= 256 * MiB && WS_H + (size_t)88 * MiB <= WS_WFI_ALT && WS_WFO_ALT + 6 * MiB <= WS_END, "ws map");

__device__ __forceinline__ int lane_id() { int l; asm volatile("v_mbcnt_lo_u32_b32 %0, -1, 0\n\tv_mbcnt_hi_u32_b32 %0, -1, %0" : "=v"(l)); return l; }
__device__ __forceinline__ int launder(int v) { asm volatile("" : "+v"(v)); return v; }
__device__ __forceinline__ float bf2f(unsigned short b) { return __uint_as_float(((unsigned)b) << 16); }
__device__ __forceinline__ unsigned f2bf(float f) { unsigned u = __float_as_uint(f); return (u + 0x7fffu + ((u >> 16) & 1u)) >> 16; }
__device__ __forceinline__ unsigned pk2(float lo, float hi) { return f2bf(lo) | (f2bf(hi) << 16); }
__device__ __forceinline__ float shfl_xor_f(float v, int mask) {
    int l; asm volatile("v_mbcnt_lo_u32_b32 %0, -1, 0\n\tv_mbcnt_hi_u32_b32 %0, -1, %0" : "=v"(l));
    return __int_as_float(__builtin_amdgcn_ds_bpermute((l ^ mask) << 2, __float_as_int(v)));
}
__device__ __forceinline__ float wave_sum(float v) {
#pragma unroll
    for (int o = 1; o < 64; o <<= 1) v += shfl_xor_f(v, o);
    return v;
}
__device__ __forceinline__ float wave_max(float v) {
#pragma unroll
    for (int o = 1; o < 64; o <<= 1) v = fmaxf(v, shfl_xor_f(v, o));
    return v;
}
__device__ __forceinline__ float fast_exp2(float x) { return __builtin_amdgcn_exp2f(x); }
__device__ __forceinline__ float fast_rcp(float x) { return __builtin_amdgcn_rcpf(x); }
__device__ __forceinline__ float sigmoidf_(float x) { return fast_rcp(1.0f + fast_exp2(-x * LOG2E)); }

using pg8::u32x4; using pg8::bf16_t; using pg8::Unit; using pg8::HALF; using pg8::BM; using pg8::cvt_pk_bf16;

__device__ __forceinline__ float row_rstd(const float* SS, int row) {
    const f32x4* p = (const f32x4*)(SS + (size_t)row * 16);
    const f32x4 a = p[0], b = p[1], c = p[2], d = p[3];
    const float t = (((a[0] + a[1]) + (a[2] + a[3])) + ((b[0] + b[1]) + (b[2] + b[3]))) + (((c[0] + c[1]) + (c[2] + c[3])) + ((d[0] + d[1]) + (d[2] + d[3])));
    return rsqrtf(t * (1.0f / DM) + EPS);
}
struct EpiSwiGLU {
    static constexpr bool PERM = true, AFTER_DRAIN = false;
    bf16_t* H; const float* SS;
    __device__ __forceinline__ void operator()(const f32x4 (&acc)[2][2][4][2], const Unit& u, int wr, int wc, int fr, int fq) const {
        const int row0 = u.pm * BM + wr * 64 + fr, col0 = u.pn * 128 + wc * 32 + 8 * fq;
#pragma unroll
        for (int ai = 0; ai < 2; ++ai)
#pragma unroll
            for (int m = 0; m < 4; ++m) {
                float h[8];
                const float rs = row_rstd(SS, row0 + ai * HALF + m * 16);
                const float na = -rs * LOG2E, rs2 = rs * rs;
#pragma unroll
                for (int n = 0; n < 2; ++n)
#pragma unroll
                    for (int e = 0; e < 4; e += 2) {
                        typedef float f32x2 __attribute__((ext_vector_type(2)));
                        const f32x2 g = (f32x2){acc[ai][0][m][n][e], acc[ai][0][m][n][e + 1]}, up = (f32x2){acc[ai][1][m][n][e], acc[ai][1][m][n][e + 1]};
                        const f32x2 t = g * na; f32x2 ex; ex.x = fast_exp2(t.x); ex.y = fast_exp2(t.y);
                        const f32x2 d = ex + 1.0f; f32x2 r; r.x = fast_rcp(d.x); r.y = fast_rcp(d.y);
                        const f32x2 hv = (g * up) * rs2 * r;
                        h[n * 4 + e] = hv.x; h[n * 4 + e + 1] = hv.y;
                    }
                u32x4 w; w.x = cvt_pk_bf16(h[0], h[1]); w.y = cvt_pk_bf16(h[2], h[3]); w.z = cvt_pk_bf16(h[4], h[5]); w.w = cvt_pk_bf16(h[6], h[7]);
                *(u32x4*)(H + (size_t)(row0 + ai * HALF + m * 16) * FF + col0) = w;
            }
    }
};
struct EpiResid {
    static constexpr bool PERM = true, AFTER_DRAIN = false;
    float* xout; bf16_t* XB; float* SSn; float s; int last;
    __device__ __forceinline__ void operator()(const f32x4 (&acc)[2][2][4][2], const Unit& u, int wr, int wc, int fr, int fq) const {
        const int row0 = u.pm * BM + wr * 64 + fr, col0 = u.pn * BM + wc * 32 + 8 * fq;
#pragma unroll
        for (int ai = 0; ai < 2; ++ai)
#pragma unroll
            for (int m = 0; m < 4; ++m) {
                float ss = 0.f;
#pragma unroll
                for (int bj = 0; bj < 2; ++bj) {
                    const size_t off = (size_t)(row0 + ai * HALF + m * 16) * DM + col0 + bj * HALF;
                    const u32x4 xw = *(const u32x4*)(XB + off);
                    f32x4 y0, y1;
                    y0[0] = __uint_as_float(xw.x << 16); y0[1] = __uint_as_float(xw.x & 0xffff0000u); y0[2] = __uint_as_float(xw.y << 16); y0[3] = __uint_as_float(xw.y & 0xffff0000u);
                    y1[0] = __uint_as_float(xw.z << 16); y1[1] = __uint_as_float(xw.z & 0xffff0000u); y1[2] = __uint_as_float(xw.w << 16); y1[3] = __uint_as_float(xw.w & 0xffff0000u);
                    y0 = y0 + acc[ai][bj][m][0] * s; y1 = y1 + acc[ai][bj][m][1] * s;
                    if (last) { *(f32x4*)(xout + off) = y0; *(f32x4*)(xout + off + 4) = y1; }
                    else {
                        u32x4 w; w.x = cvt_pk_bf16(y0[0], y0[1]); w.y = cvt_pk_bf16(y0[2], y0[3]); w.z = cvt_pk_bf16(y1[0], y1[1]); w.w = cvt_pk_bf16(y1[2], y1[3]);
                        *(u32x4*)(XB + off) = w;
                        ss += (y0[0] * y0[0] + y0[1] * y0[1]) + (y0[2] * y0[2] + y0[3] * y0[3]) + (y1[0] * y1[0] + y1[1] * y1[1]) + (y1[2] * y1[2] + y1[3] * y1[3]);
                    }
                }
                if (!last) { ss += shfl_xor_f(ss, 16); ss += shfl_xor_f(ss, 32); if (fq == 0) SSn[(size_t)(row0 + ai * HALF + m * 16) * 16 + u.pn * 4 + wc] = ss; }
            }
    }
};
struct EpiProj {
    static constexpr bool PERM = true, AFTER_DRAIN = false;
    unsigned char* ws; const float* gdil; const float* gdiff; const float* SS;
    __device__ __forceinline__ void operator()(const f32x4 (&acc)[2][2][4][2], const Unit& u, int wr, int wc, int fr, int fq) const {
        const int pn = u.pn;
        bf16_t* dst; int ld, ct, mode; const float* gain = nullptr; float sc = 1.f;
        if (pn < 3)       { dst = (bf16_t*)(ws + WS_QA); ld = 768;  ct = pn;      mode = 1; gain = gdil;        sc = QSCALE; }
        else if (pn < 6)  { dst = (bf16_t*)(ws + WS_KA); ld = 768;  ct = pn - 3;  mode = 1; gain = gdil + 768; }
        else if (pn < 9)  { dst = (bf16_t*)(ws + WS_VA); ld = 768;  ct = pn - 6;  mode = 0; }
        else if (pn < 11) { dst = (bf16_t*)(ws + WS_QD); ld = 512;  ct = pn - 9;  mode = 1; gain = gdiff;       sc = QSCALE; }
        else if (pn < 13) { dst = (bf16_t*)(ws + WS_KD); ld = 512;  ct = pn - 11; mode = 1; gain = gdiff + 512; }
        else if (pn < 15) { dst = (bf16_t*)(ws + WS_VD); ld = 512;  ct = pn - 13; mode = 0; }
        else if (pn < 19) { dst = (bf16_t*)(ws + WS_GA); ld = 1024; ct = pn - 15; mode = 2; }
        else              { dst = (bf16_t*)(ws + WS_GB); ld = 1024; ct = pn - 19; mode = 2; }
        const int colw = ct * 256 + wc * 64 + 8 * fq;
        const int row0 = u.pm * BM + wr * 64 + fr;
        f32x4 gv[2][2];
#pragma unroll
        for (int bj = 0; bj < 2; ++bj)
#pragma unroll
            for (int n = 0; n < 2; ++n) gv[bj][n] = (mode == 1) ? *(const f32x4*)(gain + colw + 32 * bj + 4 * n) * sc : (f32x4){1.f, 1.f, 1.f, 1.f};
#pragma unroll
        for (int ai = 0; ai < 2; ++ai)
#pragma unroll
            for (int m = 0; m < 4; ++m) {
                f32x4 v[2][2];
                const float rs = row_rstd(SS, row0 + ai * HALF + m * 16);
#pragma unroll
                for (int bj = 0; bj < 2; ++bj)
#pragma unroll
                    for (int n = 0; n < 2; ++n) v[bj][n] = acc[ai][bj][m][n] * rs;
                if (mode == 1) {
                    float ss = 0.f;
#pragma unroll
                    for (int bj = 0; bj < 2; ++bj)
#pragma unroll
                        for (int n = 0; n < 2; ++n) { const f32x4 x = v[bj][n]; ss += (x[0] * x[0] + x[1] * x[1]) + (x[2] * x[2] + x[3] * x[3]); }
                    ss += shfl_xor_f(ss, 16); ss += shfl_xor_f(ss, 32);
                    const float r = rsqrtf(ss * (1.0f / 64.0f) + EPS);
#pragma unroll
                    for (int bj = 0; bj < 2; ++bj)
#pragma unroll
                        for (int n = 0; n < 2; ++n) v[bj][n] = v[bj][n] * r * gv[bj][n];
                } else if (mode == 2) {
                    const float na = -rs * LOG2E;
#pragma unroll
                    for (int bj = 0; bj < 2; ++bj)
#pragma unroll
                        for (int n = 0; n < 2; ++n) {
                            const f32x4 t = acc[ai][bj][m][n] * na; f32x4 ex;
#pragma unroll
                            for (int e = 0; e < 4; ++e) ex[e] = fast_exp2(t[e]);
                            const f32x4 d = ex + 1.0f;
#pragma unroll
                            for (int e = 0; e < 4; ++e) v[bj][n][e] = fast_rcp(d[e]);
                        }
                }
                bf16_t* rowp = dst + (size_t)(row0 + ai * HALF + m * 16) * ld + colw;
#pragma unroll
                for (int bj = 0; bj < 2; ++bj) {
                    u32x4 w; w.x = cvt_pk_bf16(v[bj][0][0], v[bj][0][1]); w.y = cvt_pk_bf16(v[bj][0][2], v[bj][0][3]); w.z = cvt_pk_bf16(v[bj][1][0], v[bj][1][1]); w.w = cvt_pk_bf16(v[bj][1][2], v[bj][1][3]);
                    __builtin_nontemporal_store(w, (u32x4*)(rowp + 32 * bj));
                }
            }
    }
};
template <int PASS> struct EpiMerge {
    static constexpr bool PERM = true, AFTER_DRAIN = false;
    bf16_t* Y; const bf16_t* gate;
    __device__ __forceinline__ void operator()(const f32x4 (&acc)[2][2][4][2], const Unit& u, int wr, int wc, int fr, int fq) const {
        const int row0 = u.pm * BM + wr * 64 + fr, col0 = u.pn * BM + wc * 32 + 8 * fq;
#pragma unroll
        for (int ai = 0; ai < 2; ++ai)
#pragma unroll
            for (int m = 0; m < 4; ++m)
#pragma unroll
                for (int bj = 0; bj < 2; ++bj) {
                    const size_t off = (size_t)(row0 + ai * HALF + m * 16) * DM + col0 + bj * HALF;
                    const u32x4 gw = *(const u32x4*)(gate + off);
                    float y[8];
#pragma unroll
                    for (int n = 0; n < 2; ++n)
#pragma unroll
                        for (int e = 0; e < 4; ++e) {
                            const unsigned word = gw[n * 2 + (e >> 1)]; const float g = __uint_as_float((e & 1) ? (word & 0xffff0000u) : (word << 16));
                            y[n * 4 + e] = g * acc[ai][bj][m][n][e];
                        }
                    if (PASS == 2) {
                        const u32x4 yw = *(const u32x4*)(Y + off);
#pragma unroll
                        for (int i = 0; i < 8; ++i) { const unsigned word = yw[i >> 1]; y[i] += __uint_as_float((i & 1) ? (word & 0xffff0000u) : (word << 16)); }
                    }
                    u32x4 w; w.x = cvt_pk_bf16(y[0], y[1]); w.y = cvt_pk_bf16(y[2], y[3]); w.z = cvt_pk_bf16(y[4], y[5]); w.w = cvt_pk_bf16(y[6], y[7]);
                    *(u32x4*)(Y + off) = w;
                }
    }
};

template <int MODE> __device__ __forceinline__ int colmap(int n0) {
    if (MODE == 0) return n0;
    const int pn = n0 >> 8, r = n0 & 255, bj = r >> 7, wc = (r & 127) >> 5;
    if (MODE == 1) return bj * FF + 128 * pn + 32 * wc;
    return 256 * pn + 64 * wc + 32 * bj;
}
template <int MODE> __device__ __forceinline__ void convert_item(const float* W, const float* g, int K, int Nsrc, int Nphys, bf16* WT, LAS float* scr, int item, int lane) {
    const int nblk = Nphys / 32;
    const int kb = item / nblk, nb = item % nblk, k0 = 64 * kb, n0 = 32 * nb, s0 = colmap<MODE>(n0);
    {
        const int kr = lane >> 3, c4 = lane & 7;
        const float* src = W + (size_t)(k0 + kr) * Nsrc + s0 + 4 * c4;
        f32x4 v[8];
#pragma unroll
        for (int i = 0; i < 8; ++i) v[i] = *(const f32x4*)(src + (size_t)(8 * i) * Nsrc);
        if (g) {
#pragma unroll
            for (int i = 0; i < 8; ++i) v[i] = v[i] * g[k0 + 8 * i + kr];
        }
#pragma unroll
        for (int i = 0; i < 8; ++i) { LAS float* d = scr + (8 * i + kr) * 33 + 4 * c4; d[0] = v[i][0]; d[1] = v[i][1]; d[2] = v[i][2]; d[3] = v[i][3]; }
    }
    asm volatile("s_waitcnt lgkmcnt(0)" ::: "memory");
    const int c = lane & 7;
#pragma unroll
    for (int j = 0; j < 4; ++j) { const int n = (lane >> 3) + 8 * j; const LAS float* s = scr + (8 * c) * 33 + n;
        v4u o; o.x = pk2(s[0 * 33], s[1 * 33]); o.y = pk2(s[2 * 33], s[3 * 33]); o.z = pk2(s[4 * 33], s[5 * 33]); o.w = pk2(s[6 * 33], s[7 * 33]);
        *(v4u*)(WT + (size_t)(n0 + n) * K + k0 + 8 * c) = o; }
    asm volatile("s_waitcnt lgkmcnt(0)" ::: "memory");
}
template <int MODE> __device__ __forceinline__ void convert_weight(const float* W, const float* g, int K, int Nsrc, int Nphys, bf16* WT, LAS float* scr, int gw, int NGW, int lane_in) {
    const int lane = launder(lane_in);
    const int nitems = (K / 64) * (Nphys / 32);
    for (int item = gw; item < nitems; item += NGW) convert_item<MODE>(W, g, K, Nsrc, Nphys, WT, scr, item, lane);
}
__device__ __forceinline__ int grab_item(unsigned* ctr, int lane) {
    unsigned v = 0; if (lane == 0) v = atomicAdd(ctr, 1u);
    return __builtin_amdgcn_readfirstlane((int)v);
}
__device__ __forceinline__ void ffn_jobs(unsigned* ctr, const float* wi, const float* g, const float* wo, bf16* WFIu, bf16* WFOu, LAS float* scr, int lane_in) {
    const int lane = launder(lane_in);
    constexpr int N0 = (DM / 64) * (2 * FF / 32), N1 = (FF / 64) * (DM / 32);
    for (;;) { const int it = grab_item(ctr, lane); if (it >= N0 + N1) break;
        if (it < N0) convert_item<1>(wi, g, DM, 2 * FF, 2 * FF, WFIu, scr, it, lane); else convert_item<0>(wo, nullptr, FF, DM, DM, WFOu, scr, it - N0, lane); }
}
__device__ __forceinline__ void mixer_jobs(unsigned* ctr, const float* win, const float* g, const float* wa, const float* wb, const float* wo, unsigned char* ws, LAS float* scr, int lane_in) {
    const int lane = launder(lane_in);
    constexpr int N0 = (DM / 64) * (NPROJ / 32), N1 = (256 / 64) * (DM / 32), N2 = (512 / 64) * (DM / 32), N3 = (DM / 64) * (DM / 32);
    for (;;) { int it = grab_item(ctr, lane); if (it >= N0 + N1 + N2 + N3) break;
        if (it < N0) { convert_item<2>(win, g, DM, NPROJ, NPROJ, (bf16*)(ws + WS_WPR), scr, it, lane); continue; } it -= N0;
        if (it < N1) { convert_item<0>(wa, nullptr, 256, DM, DM, (bf16*)(ws + WS_WA), scr, it, lane); continue; } it -= N1;
        if (it < N2) { convert_item<0>(wb, nullptr, 512, DM, DM, (bf16*)(ws + WS_WB), scr, it, lane); continue; } it -= N2;
        convert_item<0>(wo, nullptr, DM, DM, DM, (bf16*)(ws + WS_WO), scr, it, lane); }
}
__device__ __forceinline__ void prologue_rows(const float* x, bf16* XB, float* SS0, int gw, int NGW, int lane_in) {
    const int lane = launder(lane_in);
    for (int m0 = gw; m0 < M; m0 += 4 * NGW) {
        f32x4 v[4][4];
#pragma unroll
        for (int q = 0; q < 4; ++q) { const int m = m0 + q * NGW; if (m < M) { const f32x4* xr = (const f32x4*)(x + (size_t)m * DM) + lane;
#pragma unroll
            for (int j = 0; j < 4; ++j) v[q][j] = xr[64 * j]; } }
#pragma unroll
        for (int q = 0; q < 4; ++q) { const int m = m0 + q * NGW; if (m < M) {
            float s = 0.f;
#pragma unroll
            for (int j = 0; j < 4; ++j) s += (v[q][j].x * v[q][j].x + v[q][j].y * v[q][j].y) + (v[q][j].z * v[q][j].z + v[q][j].w * v[q][j].w);
            s = wave_sum(s);
            unsigned long long* o8 = (unsigned long long*)(XB + (size_t)m * DM) + lane;
#pragma unroll
            for (int j = 0; j < 4; ++j) o8[64 * j] = (unsigned long long)pk2(v[q][j].x, v[q][j].y) | ((unsigned long long)pk2(v[q][j].z, v[q][j].w) << 32);
            if (lane < 16) SS0[(size_t)m * 16 + lane] = (lane == 0) ? s : 0.f; } }
    }
}
namespace att {
typedef short bf16x8 __attribute__((ext_vector_type(8)));
typedef short s16x4 __attribute__((ext_vector_type(4)));
typedef float f32x16 __attribute__((ext_vector_type(16)));
constexpr int KP = 144, VP64 = 192, VP128 = 320, STAGE = 43008, OFF_K1 = 9216, OFF_V = 18432, V1STEP = 12288;
struct UnitP {
    const bf16* Q; const bf16* K; const bf16* V; bf16* O;
    int pitch, scol;
    int qrow0, krow0, rs;
    int t0, t1;
    int D0, maxdist;
    float c0, c1;
    float lam, onem; const float* sub;
    float* lse; int lsecol;
    float bnd0, bnd1;
};
__device__ __forceinline__ s16x4 vtr(const LAS unsigned char* p) {
    typedef short v4i16_t __attribute__((ext_vector_type(4)));
    return __builtin_bit_cast(s16x4, __builtin_amdgcn_ds_read_tr16_b64_v4i16((LAS v4i16_t*)p));
}
__device__ __forceinline__ unsigned cvtpk(float lo, float hi) { unsigned r; asm volatile("v_cvt_pk_bf16_f32 %0, %1, %2" : "=v"(r) : "v"(lo), "v"(hi)); return r; }
__device__ __forceinline__ bf16x8 pack8(float a, float b, float c, float d, float e, float f, float g, float h) {
    v4u w; w.x = cvtpk(a, b); w.y = cvtpk(c, d); w.z = cvtpk(e, f); w.w = cvtpk(g, h); return __builtin_bit_cast(bf16x8, w);
}
template <bool DIFF, bool FAST>
__device__ __forceinline__ void attn_unit(LAS unsigned char* lds, const UnitP& P, const int wave, const int lane_in) {
    const int lane = launder(lane_in);
    constexpr int NDB = DIFF ? 4 : 2, VP = DIFF ? VP128 : VP64;
    const int sidx = wave >> 2, w4 = wave & 3, r32 = lane & 31, hi = lane >> 5, tid = wave * 64 + lane;
    const int qidx = 32 * w4 + r32;
    bf16x8 qf[4];
    { const bf16* qp = P.Q + (size_t)(P.qrow0 + qidx * P.rs) * P.pitch + sidx * P.scol + hi * 8;
#pragma unroll
      for (int ks = 0; ks < 4; ++ks) qf[ks] = *(const bf16x8*)(qp + ks * 16); }
    const size_t tstep = (size_t)64 * P.rs * P.pitch;
    const bf16* kg; const bf16* vg; int kl, vl;
    { const int ss = tid >> 8, u = tid & 255, kk = u >> 2, cp = u & 3;
      kg = P.K + ss * P.scol + cp * 16 + (long long)(P.krow0 + kk * P.rs) * P.pitch; kl = ss * OFF_K1 + kk * KP + cp * 32;
      if (DIFF) { const int kkv = tid >> 3, cpv = tid & 7; vg = P.V + cpv * 16 + (long long)(P.krow0 + kkv * P.rs) * P.pitch; vl = OFF_V + kkv * VP128 + cpv * 32; }
      else { vg = P.V + ss * P.scol + cp * 16 + (long long)(P.krow0 + kk * P.rs) * P.pitch; vl = OFF_V + ss * V1STEP + kk * VP64 + cp * 32; } }
    v4u rk0, rk1, rv0, rv1;
#define ATT_LOADT(t) do { const bf16* a_ = kg + (size_t)(t) * tstep; rk0 = *(const v4u*)a_; rk1 = *(const v4u*)(a_ + 8); const bf16* b_ = vg + (size_t)(t) * tstep; rv0 = *(const v4u*)b_; rv1 = *(const v4u*)(b_ + 8); } while (0)
#define ATT_STORET(st) do { LAS unsigned char* base_ = lds + (st) * STAGE; *(LAS v4u*)(base_ + kl) = rk0; *(LAS v4u*)(base_ + kl + 16) = rk1; *(LAS v4u*)(base_ + vl) = rv0; *(LAS v4u*)(base_ + vl + 16) = rv1; } while (0)
    float m_run = -INFINITY, l_run = 0.f;
    f32x16 o[NDB];
#pragma unroll
    for (int db = 0; db < NDB; ++db)
#pragma unroll
        for (int r = 0; r < 16; ++r) o[db][r] = 0.f;
    const float c = sidx ? P.c1 : P.c0;
    const float maxdf = (float)P.maxdist;
    const float bnd = sidx ? P.bnd1 : P.bnd0;
    f32x16 pat0, pat1;
    if (FAST) {
#pragma unroll
        for (int r = 0; r < 16; ++r) { pat0[r] = c * (float)((r & 3) + 8 * (r >> 2)); pat1[r] = pat0[r] + 32.f * c; }
    }
    ATT_LOADT(P.t0); ATT_STORET(0); __syncthreads();
    int stg = 0;
    for (int t = P.t0; t < P.t1; ++t) {
        const bool more = (t + 1 < P.t1);
        if (more) ATT_LOADT(t + 1);
        const int dbw = P.D0 - 64 * t + 32 * w4;
        if (dbw + 31 >= 0 && dbw - 63 <= P.maxdist) {
            const LAS unsigned char* Kt = lds + stg * STAGE + sidx * OFF_K1;
            const LAS unsigned char* Vt = lds + stg * STAGE + OFF_V + (DIFF ? 0 : sidx * V1STEP);
            f32x16 p0, p1;
            const LAS unsigned char* ka = Kt + r32 * KP + hi * 16;
            const float dl = (float)(dbw + r32 - 4 * hi);
            if (FAST) {
#pragma unroll
                for (int ks = 0; ks < 4; ++ks) {
                    const bf16x8 k0 = *(const LAS bf16x8*)(ka + ks * 32), k1 = *(const LAS bf16x8*)(ka + 32 * KP + ks * 32);
                    p0 = __builtin_amdgcn_mfma_f32_32x32x16_bf16(k0, qf[ks], ks == 0 ? pat0 : p0, 0, 0, 0);
                    p1 = __builtin_amdgcn_mfma_f32_32x32x16_bf16(k1, qf[ks], ks == 0 ? pat1 : p1, 0, 0, 0);
                }
                const float mm = bnd + c * dl;
                float ls = 0.f;
                if (dbw - 63 >= 0 && dbw + 31 <= P.maxdist) {
#pragma unroll
                    for (int r = 0; r < 16; ++r) { p0[r] = fast_exp2(p0[r] - mm); p1[r] = fast_exp2(p1[r] - mm); ls += p0[r] + p1[r]; }
                } else {
#pragma unroll
                    for (int r = 0; r < 16; ++r) {
                        const float d0 = dl - (float)((r & 3) + 8 * (r >> 2)), d1 = d0 - 32.f;
                        const float e0 = fast_exp2(p0[r] - mm), e1 = fast_exp2(p1[r] - mm);
                        p0[r] = (d0 >= 0.f && d0 <= maxdf) ? e0 : 0.f; p1[r] = (d1 >= 0.f && d1 <= maxdf) ? e1 : 0.f; ls += p0[r] + p1[r];
                    }
                }
                l_run += ls;
            } else {
#pragma unroll
            for (int r = 0; r < 16; ++r) { p0[r] = 0.f; p1[r] = 0.f; }
#pragma unroll
            for (int ks = 0; ks < 4; ++ks) {
                const bf16x8 k0 = *(const LAS bf16x8*)(ka + ks * 32), k1 = *(const LAS bf16x8*)(ka + 32 * KP + ks * 32);
                p0 = __builtin_amdgcn_mfma_f32_32x32x16_bf16(k0, qf[ks], p0, 0, 0, 0);
                p1 = __builtin_amdgcn_mfma_f32_32x32x16_bf16(k1, qf[ks], p1, 0, 0, 0);
            }
            float mt = -INFINITY;
#pragma unroll
            for (int r = 0; r < 16; ++r) {
                const float d0 = dl - (float)((r & 3) + 8 * (r >> 2)), d1 = d0 - 32.f;
                float s0 = fmaf(-c, d0, p0[r]), s1 = fmaf(-c, d1, p1[r]);
                s0 = (d0 >= 0.f && d0 <= maxdf) ? s0 : -INFINITY; s1 = (d1 >= 0.f && d1 <= maxdf) ? s1 : -INFINITY;
                p0[r] = s0; p1[r] = s1; mt = fmaxf(mt, fmaxf(s0, s1));
            }
            mt = fmaxf(mt, shfl_xor_f(mt, 32));
            const float m_new = fmaxf(m_run, mt), m_use = (m_new == -INFINITY) ? 0.f : m_new;
            const float alpha = fast_exp2(m_run - m_use);
            m_run = m_new;
            float ls = 0.f;
#pragma unroll
            for (int r = 0; r < 16; ++r) { p0[r] = fast_exp2(p0[r] - m_use); p1[r] = fast_exp2(p1[r] - m_use); ls += p0[r] + p1[r]; }
            l_run = l_run * alpha + ls;
            if (!__all(alpha == 1.f)) {
#pragma unroll
                for (int db = 0; db < NDB; ++db)
#pragma unroll
                    for (int r = 0; r < 16; ++r) o[db][r] *= alpha;
            }
            }
            bf16x8 pk[4];
            pk[0] = pack8(p0[0], p0[1], p0[2], p0[3], p0[4], p0[5], p0[6], p0[7]); pk[1] = pack8(p0[8], p0[9], p0[10], p0[11], p0[12], p0[13], p0[14], p0[15]);
            pk[2] = pack8(p1[0], p1[1], p1[2], p1[3], p1[4], p1[5], p1[6], p1[7]); pk[3] = pack8(p1[8], p1[9], p1[10], p1[11], p1[12], p1[13], p1[14], p1[15]);
            const LAS unsigned char* va = Vt + (4 * hi + ((lane & 15) >> 2)) * VP + (16 * ((lane >> 4) & 1) + 4 * (lane & 3)) * 2;
            s16x4 vlo[2][NDB], vhi[2][NDB];
            const unsigned vaddr = (unsigned)(size_t)va;
#define ATT_TR(dst, off) asm volatile("ds_read_b64_tr_b16 %0, %1 offset:%c2" : "=&v"(dst) : "v"(vaddr), "i"(off) : "memory")
#pragma unroll
            for (int db = 0; db < NDB; ++db) { ATT_TR(vlo[0][db], db * 64); ATT_TR(vhi[0][db], 8 * VP + db * 64); }
#pragma unroll
            for (int s = 0; s < 4; ++s) {
                if (s < 3) {
#pragma unroll
                    for (int db = 0; db < NDB; ++db) { ATT_TR(vlo[(s + 1) & 1][db], (16 * (s + 1)) * VP + db * 64); ATT_TR(vhi[(s + 1) & 1][db], (16 * (s + 1) + 8) * VP + db * 64); }
                    if (NDB == 4) asm volatile("s_waitcnt lgkmcnt(8)" ::: "memory"); else asm volatile("s_waitcnt lgkmcnt(4)" ::: "memory");
                } else asm volatile("s_waitcnt lgkmcnt(0)" ::: "memory");
                __builtin_amdgcn_sched_barrier(0);
                __builtin_amdgcn_s_setprio(1);
#pragma unroll
                for (int db = 0; db < NDB; ++db) {
                    s16x4 lo = vlo[s & 1][db], hh = vhi[s & 1][db];
                    asm volatile("" : "+v"(lo), "+v"(hh));
                    const bf16x8 vf = (bf16x8){lo[0], lo[1], lo[2], lo[3], hh[0], hh[1], hh[2], hh[3]};
                    o[db] = __builtin_amdgcn_mfma_f32_32x32x16_bf16(vf, pk[s], o[db], 0, 0, 0);
                }
                __builtin_amdgcn_s_setprio(0);
                __builtin_amdgcn_sched_barrier(0);
            }
#undef ATT_TR
        }
        if (more) ATT_STORET(stg ^ 1);
        __syncthreads();
        stg ^= 1;
    }
#undef ATT_LOADT
#undef ATT_STORET
    const float l_tot = l_run + shfl_xor_f(l_run, 32);
    const float inv = 1.f / l_tot;
    if (!DIFF) {
        bf16* op = P.O + (size_t)(P.qrow0 + qidx * P.rs) * P.pitch + sidx * P.scol + 4 * hi;
#pragma unroll
        for (int db = 0; db < NDB; ++db)
#pragma unroll
            for (int rq = 0; rq < 4; ++rq) {
                const unsigned w0 = cvtpk(o[db][4 * rq] * inv, o[db][4 * rq + 1] * inv), w1 = cvtpk(o[db][4 * rq + 2] * inv, o[db][4 * rq + 3] * inv);
                *(unsigned long long*)(op + 32 * db + 8 * rq) = (unsigned long long)w0 | ((unsigned long long)w1 << 32);
            }
        if (hi == 0) P.lse[(size_t)(P.qrow0 + qidx * P.rs) * 12 + P.lsecol + sidx] = (FAST ? bnd : m_run) + log2f(l_tot);
    } else {
        LAS float* X = (LAS float*)lds;
        if (sidx == 1) {
            const float sc = P.lam * inv;
#pragma unroll
            for (int db = 0; db < NDB; ++db)
#pragma unroll
                for (int r = 0; r < 16; ++r) X[((w4 * 4 + db) * 16 + r) * 64 + lane] = o[db][r] * sc;
        }
        __syncthreads();
        if (sidx == 0) {
            float ss = 0.f;
#pragma unroll
            for (int db = 0; db < NDB; ++db)
#pragma unroll
                for (int r = 0; r < 16; ++r) { const float v = o[db][r] * inv - X[((w4 * 4 + db) * 16 + r) * 64 + lane]; o[db][r] = v; ss += v * v; }
            ss += shfl_xor_f(ss, 32);
            const float rr = rsqrtf(ss * (1.f / 128.f) + EPS) * P.onem;
            bf16* op = P.O + (size_t)(P.qrow0 + qidx) * P.pitch + 4 * hi;
            const float* gp = P.sub + 4 * hi;
#pragma unroll
            for (int db = 0; db < NDB; ++db)
#pragma unroll
                for (int rq = 0; rq < 4; ++rq) {
                    const f32x4 g = *(const f32x4*)(gp + 32 * db + 8 * rq);
                    const unsigned w0 = cvtpk(o[db][4 * rq] * rr * g[0], o[db][4 * rq + 1] * rr * g[1]), w1 = cvtpk(o[db][4 * rq + 2] * rr * g[2], o[db][4 * rq + 3] * rr * g[3]);
                    *(unsigned long long*)(op + 32 * db + 8 * rq) = (unsigned long long)w0 | ((unsigned long long)w1 << 32);
                }
        }
        __syncthreads();
    }
}
__device__ __forceinline__ float slope2(int head) { return exp2f(-0.5f * (float)(head + 1)) * LOG2E; }
__device__ __forceinline__ float qk_bound(const float* gq, const float* gk, int lane) {
    return 64.f * QSCALE * wave_max(fabsf(gq[lane])) * wave_max(fabsf(gk[lane])) * 1.02f + 0.25f;
}
__device__ __forceinline__ void diff_phase(LAS unsigned char* lds, unsigned char* ws, const float* sub, const float* bnds, float lam, float lam_init, int bx, int G, int wave, int lane, bf16* Oalt = nullptr) {
    for (int it = bx; it < 256; it += G) {
        const int b = it & 7, h = (it >> 6) & 3, p = (it >> 3) & 7;
        for (int half = 0; half < 2; ++half) {
            const int qb = half ? 15 - p : p;
            UnitP P;
            P.Q = (const bf16*)(ws + WS_QD) + h * 128; P.K = (const bf16*)(ws + WS_KD) + h * 128; P.V = (const bf16*)(ws + WS_VD) + h * 128; P.O = (Oalt ? Oalt : (bf16*)(ws + WS_QD)) + h * 128;
            P.pitch = 512; P.scol = 64; P.qrow0 = b * SEQ + qb * 128; P.krow0 = b * SEQ; P.rs = 1; P.t0 = 0; P.t1 = 2 * (qb + 1);
            P.D0 = qb * 128; P.maxdist = 1 << 20; P.c0 = P.c1 = slope2(12 + h); P.lam = lam; P.onem = 1.f - lam_init; P.sub = sub + h * 128; P.lse = nullptr; P.lsecol = 0;
            P.bnd0 = bnds[12 + 2 * h]; P.bnd1 = bnds[13 + 2 * h];
            if (P.bnd0 <= 40.f && P.bnd1 <= 40.f) attn_unit<true, true>(lds, P, wave, lane); else attn_unit<true, false>(lds, P, wave, lane);
        }
    }
}
__device__ __forceinline__ void dil_phase(LAS unsigned char* lds, unsigned char* ws, const float* bnds, int bx, int G, int wave, int lane, bf16* Oalt = nullptr) {
    for (int u = bx; u < 768; u += G) {
        int pair, g, r, n;
        const int b = u & 7, v = u >> 3;
        if (v < 54) { pair = v / 27; const int j = v % 27; if (j < 15) { g = 0; r = 0; n = j + 1; } else { g = 1; r = (j - 15) / 3; n = (j - 15) % 3 + 1; } }
        else { const int w = v - 54; pair = w / 21; const int j = w % 21; n = 0; if (j == 0) { g = 0; r = 0; } else if (j < 5) { g = 1; r = j - 1; } else { g = 2; r = j - 5; } }
        const int hg0 = pair * 2, dil = 1 << (2 * g), head = g * 4 + hg0;
        UnitP P;
        P.Q = (const bf16*)(ws + WS_QA) + head * 64; P.K = (const bf16*)(ws + WS_KA) + head * 64; P.V = (const bf16*)(ws + WS_VA) + head * 64; P.O = (Oalt ? Oalt : (bf16*)(ws + WS_QA)) + head * 64;
        P.pitch = 768; P.scol = 64; P.rs = dil; P.qrow0 = b * SEQ + r + n * 128 * dil; P.krow0 = b * SEQ + r + (n - 1) * 128 * dil;
        P.t0 = (n == 0) ? 2 : 0; P.t1 = 4; P.D0 = 128; P.maxdist = 128; P.c0 = slope2(head) * (float)dil; P.c1 = slope2(head + 1) * (float)dil;
        P.lam = 0.f; P.onem = 0.f; P.sub = nullptr; P.lse = (float*)(ws + WS_LSE); P.lsecol = head;
        P.bnd0 = bnds[head]; P.bnd1 = bnds[head + 1];
        if (P.bnd0 <= 40.f && P.bnd1 <= 40.f) attn_unit<false, true>(lds, P, wave, lane); else attn_unit<false, false>(lds, P, wave, lane);
    }
}
__device__ __forceinline__ void dil_combine(unsigned char* ws, int gw, int NGW, int lane_in) {
    const int lane = launder(lane_in);
    const bf16* OG = (const bf16*)(ws + WS_QA); const float* LSE = (const float*)(ws + WS_LSE); bf16* OD = (bf16*)(ws + WS_ODIL);
    for (int item = gw; item < M; item += NGW) {
        const int row = ((item >> 3) & 7) * SEQ + ((item >> 6) << 3) + (item & 7), hg = lane >> 4, c4 = (lane & 15) * 4;
        const float l0 = LSE[(size_t)row * 12 + hg], l1 = LSE[(size_t)row * 12 + 4 + hg], l2 = LSE[(size_t)row * 12 + 8 + hg];
        const float mx = fmaxf(l0, fmaxf(l1, l2)), e0 = exp2f(l0 - mx), e1 = exp2f(l1 - mx), e2 = exp2f(l2 - mx), is = 1.f / (e0 + e1 + e2);
        const float a0 = e0 * is, a1 = e1 * is, a2 = e2 * is;
        const unsigned long long w0 = *(const unsigned long long*)(OG + (size_t)row * 768 + hg * 64 + c4), w1 = *(const unsigned long long*)(OG + (size_t)row * 768 + 256 + hg * 64 + c4),
                                 w2 = *(const unsigned long long*)(OG + (size_t)row * 768 + 512 + hg * 64 + c4);
        float y[4];
#pragma unroll
        for (int e = 0; e < 4; ++e) y[e] = a0 * bf2f((unsigned short)(w0 >> (16 * e))) + a1 * bf2f((unsigned short)(w1 >> (16 * e))) + a2 * bf2f((unsigned short)(w2 >> (16 * e)));
        *(unsigned long long*)(OD + (size_t)row * 768 + hg * 64 + c4) = (unsigned long long)pk2(y[0], y[1]) | ((unsigned long long)pk2(y[2], y[3]) << 32);
    }
}
}

#define XB_TMO      128
#define XB_XCNT(j)  (256  + 64 * (j))
#define XB_XSUB(j)  (1280 + 64 * (j))
#define XB_XGEN(j)  (2304 + 64 * (j))
#define XB_TOP      3328
#define XB_TOPGEN   3392
#define XCD_BAR_WORDS 3456
#define XB_EXIT 3456
#define XB_SPIN_CAP (1u << 18)

__device__ __forceinline__ unsigned xb_ld(unsigned* p)              { return __hip_atomic_load(p, __ATOMIC_RELAXED, __HIP_MEMORY_SCOPE_AGENT); }
__device__ __forceinline__ unsigned xb_add(unsigned* p, unsigned v) { return __hip_atomic_fetch_add(p, v, __ATOMIC_RELAXED, __HIP_MEMORY_SCOPE_AGENT); }
__device__ __forceinline__ unsigned xb_xcc_id() { return (unsigned)__builtin_amdgcn_s_getreg((3 << 11) | 20) & 0xFu; }
#define XB_SPIN(cond, bar) do { unsigned _sp = 0; while (cond) { __builtin_amdgcn_s_sleep(1); \
    if ((++_sp & 255u) == 0u) { if (xb_ld(&(bar)[XB_TMO])) break; if (_sp > XB_SPIN_CAP) { atomicAdd(&(bar)[XB_TMO], 1u); break; } } } } while (0)

__device__ unsigned g_barwords[XCD_BAR_WORDS + 64];
struct XcdBarrier {
    unsigned* bar; unsigned x;
    volatile LAS unsigned* st;
};

__device__ __forceinline__ XcdBarrier xcd_barrier_post(unsigned* bar, volatile LAS unsigned* st, bool t0) {
    XcdBarrier b; b.bar = bar; b.x = xb_xcc_id(); b.st = st;
    if (t0) (void)xb_add(&bar[XB_XCNT(b.x)], 1u);
    return b;
}
__device__ __forceinline__ void xcd_barrier_complete(unsigned* bar, unsigned x, unsigned& nloc, unsigned& nx) {
    const unsigned G = gridDim.x * gridDim.y * gridDim.z;
    unsigned sum, cnt, mine, sp = 0u;
    for (;;) {
        sum = 0u; cnt = 0u; mine = 0u;
#pragma unroll
        for (unsigned j = 0; j < 16; ++j) { const unsigned c = xb_ld(&bar[XB_XCNT(j)]); sum += c; cnt += (c > 0u) ? 1u : 0u; mine = (j == x) ? c : mine; }
        if (sum == G) break;
        __builtin_amdgcn_s_sleep(1);
        if ((++sp & 255u) == 0u) { if (xb_ld(&bar[XB_TMO])) break; if (sp > XB_SPIN_CAP) { atomicAdd(&bar[XB_TMO], 1u); break; } }
    }
    nloc = mine > 0u ? mine : 1u; nx = cnt > 0u ? cnt : 1u;
}

__device__ __forceinline__ void xcd_barrier(const XcdBarrier& b, bool t0) {
    asm volatile("s_waitcnt vmcnt(0)" ::: "memory");
    __syncthreads();
    if (t0) {
        unsigned* bar = b.bar;
        __builtin_amdgcn_s_waitcnt(0);
        unsigned nloc = b.st[0], nx = b.st[1];
        if (nloc == 0u) { xcd_barrier_complete(bar, b.x, nloc, nx); b.st[0] = nloc; b.st[1] = nx; }
        const unsigned old = xb_add(&bar[XB_XSUB(b.x)], 1u);
        const unsigned gen = old / nloc;
        if (old + 1u == (gen + 1u) * nloc) {
            __builtin_amdgcn_fence(__ATOMIC_RELEASE, "agent");
            asm volatile("s_waitcnt vmcnt(0)" ::: "memory");
            const unsigned og = xb_add(&bar[XB_TOP], 1u);
            const unsigned tg = og / nx;
            if (og + 1u == (tg + 1u) * nx) xb_add(&bar[XB_TOPGEN], 1u);
            else XB_SPIN(xb_ld(&bar[XB_TOPGEN]) == tg, bar);
            __builtin_amdgcn_fence(__ATOMIC_ACQUIRE, "agent");
            xb_add(&bar[XB_XGEN(b.x)], 1u);
            asm volatile("s_waitcnt vmcnt(0)" ::: "memory");
        } else {
            XB_SPIN(xb_ld(&bar[XB_XGEN(b.x)]) == gen, bar);
            __builtin_amdgcn_fence(__ATOMIC_ACQUIRE, "agent");
            asm volatile("s_waitcnt vmcnt(0)" ::: "memory");
        }
    }
    __syncthreads();
}

#define XB_FLAG 192
__device__ __forceinline__ void xcc_local_barrier(unsigned* bar, unsigned x, unsigned nloc, bool t0) {
    asm volatile("s_waitcnt vmcnt(0)" ::: "memory");
    __syncthreads();
    if (t0) {
        __builtin_amdgcn_s_waitcnt(0);
        const unsigned old = xb_add(&bar[XB_XSUB(x)], 1u), gen = old / nloc;
        if (old + 1u == (gen + 1u) * nloc) xb_add(&bar[XB_XGEN(x)], 1u);
        else XB_SPIN(xb_ld(&bar[XB_XGEN(x)]) == gen, bar);
        __builtin_amdgcn_fence(__ATOMIC_ACQUIRE, "agent");
        asm volatile("s_waitcnt vmcnt(0)" ::: "memory");
    }
    __syncthreads();
}
struct Args {
    const float* x; const float* ffn1_norm; const float* ffn1_w_in; const float* ffn1_w_out; const float* mix_norm; const float* w_in;
    const float* qk_gain_dil; const float* qk_gain_diff; const float* lambda_q; const float* lambda_k; const float* diff_subnorm;
    const float* w_branch_dil; const float* w_branch_diff; const float* w_out; const float* ffn2_norm; const float* ffn2_w_in; const float* ffn2_w_out;
    float* out; unsigned char* ws;
};
constexpr int LDS_BYTES = 147456;

__device__ __forceinline__ const float* ldptr(LAS unsigned long long* ptab, int i) {
    const unsigned long long v = ptab[i];
    const unsigned lo = __builtin_amdgcn_readfirstlane((unsigned)v), hi = __builtin_amdgcn_readfirstlane((unsigned)(v >> 32));
    return (const float*)(((unsigned long long)hi << 32) | lo);
}
constexpr int PTAB_OFF = LDS_BYTES - 256;
enum { I_X = 0, I_F1N, I_F1I, I_F1O, I_MN, I_WIN, I_GDIL, I_GDIFF, I_LQ, I_LK, I_SUB, I_WA, I_WB, I_WO, I_F2N, I_F2I, I_F2O, I_OUT, I_WS };
__global__ void __launch_bounds__(512, 2) fwd_kernel(Args a) {
    extern __shared__ __attribute__((aligned(16))) unsigned char lds_raw[];
    cg::grid_group grid = cg::this_grid();
    LAS unsigned char* lds = (LAS unsigned char*)lds_raw;
    if (threadIdx.x == 0) {
        LAS unsigned long long* ptab = (LAS unsigned long long*)(lds + PTAB_OFF);
        ptab[I_X] = (unsigned long long)a.x; ptab[I_F1N] = (unsigned long long)a.ffn1_norm; ptab[I_F1I] = (unsigned long long)a.ffn1_w_in; ptab[I_F1O] = (unsigned long long)a.ffn1_w_out;
        ptab[I_MN] = (unsigned long long)a.mix_norm; ptab[I_WIN] = (unsigned long long)a.w_in; ptab[I_GDIL] = (unsigned long long)a.qk_gain_dil; ptab[I_GDIFF] = (unsigned long long)a.qk_gain_diff;
        ptab[I_LQ] = (unsigned long long)a.lambda_q; ptab[I_LK] = (unsigned long long)a.lambda_k; ptab[I_SUB] = (unsigned long long)a.diff_subnorm; ptab[I_WA] = (unsigned long long)a.w_branch_dil;
        ptab[I_WB] = (unsigned long long)a.w_branch_diff; ptab[I_WO] = (unsigned long long)a.w_out; ptab[I_F2N] = (unsigned long long)a.ffn2_norm; ptab[I_F2I] = (unsigned long long)a.ffn2_w_in;
        ptab[I_F2O] = (unsigned long long)a.ffn2_w_out; ptab[I_OUT] = (unsigned long long)a.out; ptab[I_WS] = (unsigned long long)a.ws;
    }
    const int wave0 = __builtin_amdgcn_readfirstlane(threadIdx.x >> 6);
    if (threadIdx.x < 3) ((volatile LAS unsigned*)(lds + PTAB_OFF + 192))[threadIdx.x] = 0u;
    __syncthreads();
    if (a.ws == nullptr) grid.sync();
    (void)xcd_barrier_post(g_barwords, (volatile LAS unsigned*)(lds + PTAB_OFF + 192), threadIdx.x == 0);
    if (threadIdx.x == 0 && (xb_xcc_id() != (blockIdx.x & 7u) || gridDim.x != 256u)) (void)xb_add(g_barwords + XB_FLAG, 1u);
#define GRID_SYNC() do { XcdBarrier b_; b_.bar = g_barwords; b_.x = xb_xcc_id(); b_.st = (volatile LAS unsigned*)(lds + PTAB_OFF + 192 + launder(0)); xcd_barrier(b_, wave == 0 && lane_id() == 0); } while (0)
#define GRID_SYNC_L() do { volatile LAS unsigned* st_ = (volatile LAS unsigned*)(lds + PTAB_OFF + 192 + launder(0)); \
        if (__builtin_amdgcn_readfirstlane((int)st_[2])) { \
            xcc_local_barrier(g_barwords, xb_xcc_id(), (unsigned)__builtin_amdgcn_readfirstlane((int)st_[0]), wave == 0 && lane_id() == 0); \
        } else GRID_SYNC(); } while (0)

    {
        int wave = wave0; asm volatile("" : "+s"(wave));
        const int G = gridDim.x, bx = blockIdx.x, gw = bx * 8 + wave, NGW = G * 8;
        LAS unsigned long long* ptab = (LAS unsigned long long*)(lds + PTAB_OFF + launder(0));
        unsigned char* ws = (unsigned char*)ldptr(ptab, I_WS);
        LAS float* scr = (LAS float*)(lds + wave * 16384);
        float* SS = (float*)(ws + WS_SS);
        { const int ln = lane_id(); if (bx == 0 && wave == 0 && ln < 8) ((unsigned*)(ws + WS_CTR))[ln * 64] = 0u; }
        convert_weight<1>(ldptr(ptab, I_F1I), ldptr(ptab, I_F1N), DM, 2 * FF, 2 * FF, (bf16*)(ws + WS_WFI), scr, gw, NGW, lane_id());
        convert_weight<0>(ldptr(ptab, I_F1O), nullptr, FF, DM, DM, (bf16*)(ws + WS_WFO), scr, gw, NGW, lane_id());
        if (gw < 40) {
            const int l = gw / 20, j = gw % 20, ln = lane_id();
            const float* gq; const float* gk;
            if (j < 12) { gq = ldptr(ptab, I_GDIL) + (size_t)l * 1536 + j * 64; gk = gq + 768; }
            else { gq = ldptr(ptab, I_GDIFF) + (size_t)l * 1024 + (j - 12) * 64; gk = gq + 512; }
            const float b = att::qk_bound(gq, gk, ln);
            if (ln == 0) ((float*)(ws + WS_BND))[gw] = b;
        }
        prologue_rows(ldptr(ptab, I_X), (bf16*)(ws + WS_XN), SS, gw, NGW, lane_id());
        GRID_SYNC();
        if (wave == 0 && lane_id() == 0) ((volatile LAS unsigned*)(lds + PTAB_OFF + 192))[2] = (xb_ld(g_barwords + XB_FLAG) == 0u) ? 1u : 0u;
        __syncthreads();
    }
    for (int st = 0; st < 6; ++st) {
        const int l = st / 3, s = st % 3;
        int wave = wave0; asm volatile("" : "+s"(wave));
        const int G = gridDim.x, bx = blockIdx.x, gw = bx * 8 + wave, NGW = G * 8;
        LAS unsigned long long* ptab = (LAS unsigned long long*)(lds + PTAB_OFF + launder(0));
        unsigned char* ws = (unsigned char*)ldptr(ptab, I_WS);
        float* out = (float*)ldptr(ptab, I_OUT);
        bf16* XN = (bf16*)(ws + WS_XN); bf16* Hb = (bf16*)(ws + WS_H);
        const float* SScur = (const float*)(ws + WS_SS) + (size_t)(st & 1) * M * 16; float* SSnext = (float*)(ws + WS_SS) + (size_t)((st + 1) & 1) * M * 16;
        unsigned* ctrs = (unsigned*)(ws + WS_CTR);
        LAS float* scr = (LAS float*)(lds + wave * 16384);
        if (s != 1) {
            const bool alt = (s == 0 && l == 1);
            const bf16* WFIu = (const bf16*)(ws + (alt ? WS_WFI_ALT : WS_WFI)); const bf16* WFOu = (const bf16*)(ws + (alt ? WS_WFO_ALT : WS_WFO));
            { pg8::Gemm g{XN, WFIu, M, 2 * FF, DM}; pg8::StaticOrder S; S.init(M, 2 * FF, G, bx); EpiSwiGLU E{Hb, SScur};
              pg8::gemm_phase<EpiSwiGLU, pg8::StaticOrder, true, true>(lds, g, S, E, wave); }
            if (s == 0)
                mixer_jobs(ctrs + 64 * (l == 0 ? 0 : 3), ldptr(ptab, I_WIN) + (size_t)l * DM * NPROJ, ldptr(ptab, I_MN) + (size_t)l * DM, ldptr(ptab, I_WA) + (size_t)l * 256 * DM,
                           ldptr(ptab, I_WB) + (size_t)l * 512 * DM, ldptr(ptab, I_WO) + (size_t)l * DM * DM, ws, scr, lane_id());
            else if (l == 0)
                ffn_jobs(ctrs + 64 * 2, ldptr(ptab, I_F1I) + (size_t)DM * 2 * FF, ldptr(ptab, I_F1N) + DM, ldptr(ptab, I_F1O) + (size_t)FF * DM, (bf16*)(ws + WS_WFI_ALT), (bf16*)(ws + WS_WFO_ALT), scr, lane_id());
            GRID_SYNC_L();
            { pg8::Gemm g{Hb, WFOu, M, DM, FF}; pg8::StaticOrder S; S.init(M, DM, G, bx); EpiResid E{out, XN, SSnext, 0.5f, st == 5 ? 1 : 0};
              pg8::gemm_phase<EpiResid, pg8::StaticOrder, true, true>(lds, g, S, E, wave); }
            GRID_SYNC();
        } else {
            { pg8::Gemm g{XN, (const bf16*)(ws + WS_WPR), M, NPROJ, DM}; pg8::StaticOrder S; S.init(M, NPROJ, G, bx);
              EpiProj E{ws, ldptr(ptab, I_GDIL) + (size_t)l * 1536, ldptr(ptab, I_GDIFF) + (size_t)l * 1024, SScur};
              pg8::gemm_phase<EpiProj, pg8::StaticOrder, true, true>(lds, g, S, E, wave); }
            ffn_jobs(ctrs + 64 * (l == 0 ? 1 : 4), ldptr(ptab, I_F2I) + (size_t)l * DM * 2 * FF, ldptr(ptab, I_F2N) + (size_t)l * DM, ldptr(ptab, I_F2O) + (size_t)l * FF * DM, (bf16*)(ws + WS_WFI), (bf16*)(ws + WS_WFO), scr, lane_id());
            GRID_SYNC_L();
            {
                const float lam_init = 0.8f - 0.6f * expf(-0.3f * (float)l);
                const float* lq = ldptr(ptab, I_LQ) + l * 128; const float* lk = ldptr(ptab, I_LK) + l * 128;
                const int ln = lane_id();
                const float d0 = wave_sum(lq[ln] * lk[ln]), d1 = wave_sum(lq[64 + ln] * lk[64 + ln]);
                const float lam = expf(d0) - expf(d1) + lam_init;
                att::diff_phase(lds, ws, ldptr(ptab, I_SUB) + l * 512, (const float*)(ws + WS_BND) + l * 20, lam, lam_init, bx, G, wave, lane_id());
                att::dil_phase(lds, ws, (const float*)(ws + WS_BND) + l * 20, bx, G, wave, lane_id());
                GRID_SYNC_L();
                att::dil_combine(ws, gw, NGW, lane_id());
            }
            GRID_SYNC_L();
            {
            { pg8::Gemm g{(const bf16*)(ws + WS_ODIL), (const bf16*)(ws + WS_WA), M, DM, 256, 768}; pg8::StaticOrder S; S.init(M, DM, G, bx); EpiMerge<1> E{(bf16*)(ws + WS_Y), (const bf16*)(ws + WS_GA)};
              pg8::gemm_phase<EpiMerge<1>, pg8::StaticOrder, true, true>(lds, g, S, E, wave); }
            { pg8::Gemm g{(const bf16*)(ws + WS_QD), (const bf16*)(ws + WS_WB), M, DM, 512}; pg8::StaticOrder S; S.init(M, DM, G, bx); EpiMerge<2> E{(bf16*)(ws + WS_Y), (const bf16*)(ws + WS_GB)};
              pg8::gemm_phase<EpiMerge<2>, pg8::StaticOrder, true, true>(lds, g, S, E, wave); }
            }
            GRID_SYNC_L();
            { pg8::Gemm g{(const bf16*)(ws + WS_Y), (const bf16*)(ws + WS_WO), M, DM, DM}; pg8::StaticOrder S; S.init(M, DM, G, bx); EpiResid E{out, XN, SSnext, 1.0f, 0};
              pg8::gemm_phase<EpiResid, pg8::StaticOrder, true, true>(lds, g, S, E, wave); }
            GRID_SYNC();
        }
    }
    {
        int wave = wave0; asm volatile("" : "+s"(wave));
        volatile LAS unsigned* ex = (volatile LAS unsigned*)(lds + PTAB_OFF + 192 + launder(0));
        const unsigned ln = (unsigned)lane_id();
        if (wave == 0 && ln == 0u) ex[3] = (xb_add(&g_barwords[XB_EXIT], 1u) == gridDim.x - 1u) ? 1u : 0u;
        __syncthreads();
        if (ex[3]) for (unsigned i = (unsigned)wave * 64u + ln; i < XCD_BAR_WORDS + 64u; i += 512u) __hip_atomic_store(&g_barwords[i], 0u, __ATOMIC_RELAXED, __HIP_MEMORY_SCOPE_AGENT);
    }
}

extern "C" void kernel_launch(void* const* d_in, const int* in_sizes, int n_in, void* d_out, int out_size, void* d_ws, size_t ws_size, hipStream_t stream) {
    static int grid = 0;
    if (grid == 0) {
        if (n_in != 17 || out_size != M * DM || ws_size < WS_SS + 2 * MiB) { fprintf(stderr, "kernel_launch: unexpected shapes (n_in %d out %d ws %zu)\n", n_in, out_size, ws_size); grid = -1; return; }
        int dev = 0, cus = 0, per_cu = 0;
        hipGetDevice(&dev); hipDeviceGetAttribute(&cus, hipDeviceAttributeMultiprocessorCount, dev);
        hipFuncSetAttribute((const void*)fwd_kernel, hipFuncAttributeMaxDynamicSharedMemorySize, LDS_BYTES);
        hipOccupancyMaxActiveBlocksPerMultiprocessor(&per_cu, (const void*)fwd_kernel, 512, LDS_BYTES);
        if (per_cu < 1) { fprintf(stderr, "kernel_launch: occupancy query says %d blocks/CU\n", per_cu); per_cu = 1; }
        (void)hipGetLastError();
        grid = cus;
    }
    if (grid < 0) return;
    Args a{};
    a.x = (const float*)d_in[0]; a.ffn1_norm = (const float*)d_in[1]; a.ffn1_w_in = (const float*)d_in[2]; a.ffn1_w_out = (const float*)d_in[3];
    a.mix_norm = (const float*)d_in[4]; a.w_in = (const float*)d_in[5]; a.qk_gain_dil = (const float*)d_in[6]; a.qk_gain_diff = (const float*)d_in[7];
    a.lambda_q = (const float*)d_in[8]; a.lambda_k = (const float*)d_in[9]; a.diff_subnorm = (const float*)d_in[10]; a.w_branch_dil = (const float*)d_in[11];
    a.w_branch_diff = (const float*)d_in[12]; a.w_out = (const float*)d_in[13]; a.ffn2_norm = (const float*)d_in[14]; a.ffn2_w_in = (const float*)d_in[15]; a.ffn2_w_out = (const float*)d_in[16];
    a.out = (float*)d_out; a.ws = (unsigned char*)d_ws;
    void* args[] = {&a};
    hipError_t e = hipLaunchCooperativeKernel((const void*)fwd_kernel, dim3(grid), dim3(512), args, LDS_BYTES, stream);
    if (e != hipSuccess) fprintf(stderr, "kernel_launch: cooperative launch failed: %s (grid %d)\n", hipGetErrorString(e), grid);
}
```

```cpp
#include <hip/hip_runtime.h>
#include <hip/hip_cooperative_groups.h>
#include <cstdio>
#include <cstdint>
namespace cg = cooperative_groups;
namespace pg8 {
#define PG8_LAS __attribute__((address_space(3)))
typedef unsigned short bf16_t;
typedef short bf16x8 __attribute__((ext_vector_type(8)));
typedef float f32x4 __attribute__((ext_vector_type(4)));
typedef unsigned u32x4 __attribute__((ext_vector_type(4)));
constexpr int BM = 256, BK = 64, HALF = 128, HTB = HALF * BK * 2  , STAGE_BYTES = 8 * HTB, NXCD = 8, WGM = 8;

__host__ __device__ __forceinline__ int lds_byte(int r, int c) { const int st = (r >> 4) * 2 + (c >> 5), rr = r & 15, cc = c & 31, ob = rr * 64 + cc * 2; return st * 1024 + (ob ^ (((ob >> 9) & 1) << 5)); }
__host__ __device__ __forceinline__ void stage_rc(int b, int& R, int& C) { const int st = b / 1024, sb = b % 1024, swz = sb ^ (((sb >> 9) & 1) << 5); R = (st >> 1) * 16 + swz / 64; C = (st & 1) * 32 + (swz % 64) / 2; }
__host__ __device__ __forceinline__ int perm32(int rho) { const int n = rho >> 4, i = rho & 15; return 8 * (i >> 2) + 4 * n + (i & 3); }

struct Unit { int pm, pn; };
struct Gemm { const bf16_t* A; const bf16_t* Bt; int M, N, K; int lda; };

struct StaticOrder {
    int nM, nN, nwg, G, c;
    __host__ __device__ void init(int M, int N, int G_, int c_) { nM = M / BM; nN = N / BM; nwg = nM * nN; G = G_; c = c_; }
    __host__ __device__ bool next(int i, Unit& u) const {
        const long L = (long)i * G + c; if (L >= nwg) return false;
        int wgid = (int)L; { const int q = nwg / NXCD, r = nwg % NXCD, xcd = wgid % NXCD, off = wgid / NXCD; wgid = (xcd < r ? xcd * (q + 1) : r * (q + 1) + (xcd - r) * q) + off; }
        const int nig = WGM * nN, gid = wgid / nig, fm = gid * WGM, gsz = (nM - fm) < WGM ? (nM - fm) : WGM;
        u.pm = fm + ((wgid % nig) % gsz); u.pn = (wgid % nig) / gsz; return true;
    }
    __device__ __forceinline__ void a_ready(const Unit&) const {}
    __device__ __forceinline__ void done(const Unit&) const {}
};
__device__ __forceinline__ unsigned cvt_pk_bf16(float lo, float hi) { unsigned r; asm volatile("v_cvt_pk_bf16_f32 %0, %1, %2" : "=v"(r) : "v"(lo), "v"(hi)); return r; }
typedef float f32x2 __attribute__((ext_vector_type(2)));
template <class Epi, class Sched, bool ALIGN_EPI = false, bool SP2 = false>
__device__ __forceinline__ void gemm_phase(PG8_LAS unsigned char* lds, const Gemm g, const Sched& S, const Epi& E, const int wid_in) {
    int tid_; asm volatile("v_mbcnt_lo_u32_b32 %0, -1, 0\n\tv_mbcnt_hi_u32_b32 %0, -1, %0" : "=v"(tid_)); int wid_ = wid_in; asm volatile("" : "+s"(wid_)); tid_ += 64 * wid_; const int tid = tid_, wid = wid_, lane = tid & 63, wr = wid >> 2, wc = wid & 3, fr = lane & 15, fq = lane >> 4;
    const int K = g.K, nt = K / BK;
    unsigned voffA[2], voffB[2];
#pragma unroll
    for (int i = 0; i < 2; ++i) { int R, C; stage_rc(tid * 16 + i * 8192, R, C); const int Rb = Epi::PERM ? ((R & ~31) + perm32(R & 31)) : R;
        voffA[i] = (unsigned)(R * (g.lda ? g.lda : K) + C) * 2u; voffB[i] = (unsigned)(Rb * K + C) * 2u; }
    const size_t kstep = (size_t)(BK * 2);
    const size_t hstep = (size_t)HALF * K * 2;
    const size_t tstep = 2 * hstep;
    const int lda = g.lda ? g.lda : K;
    const size_t hstepA = (size_t)HALF * lda * 2, tstepA = 2 * hstepA;
    const unsigned ldsw = (unsigned)wid * 1024u;
    const int aoff = lds_byte(wr * 64 + fr, fq * 8), boff = lds_byte(wc * 32 + fr, fq * 8);
#define PG8_SA(b, h) (((b) * 2 + (h)) * HTB)
#define PG8_SB(b, h) ((4 + (b) * 2 + (h)) * HTB)
#define PG8_STAGE(bufoff, gbase, voff) do { _Pragma("unroll") for (int _i = 0; _i < 2; ++_i) \
        __builtin_amdgcn_global_load_lds((const unsigned*)((const char*)(gbase) + (voff)[_i]), (PG8_LAS unsigned*)(lds + (bufoff) + ldsw + _i * 8192), 16, 0, 0); } while (0)
#define PG8_LDA(dst, b, h) do { _Pragma("unroll") for (int m = 0; m < 4; ++m) _Pragma("unroll") for (int k = 0; k < 2; ++k) dst[m][k] = *(const PG8_LAS bf16x8*)(lds + PG8_SA(b, h) + aoff + m * 2048 + k * 1024); } while (0)
#define PG8_LDB(dst, b, h) do { _Pragma("unroll") for (int n = 0; n < 2; ++n) _Pragma("unroll") for (int k = 0; k < 2; ++k) dst[n][k] = *(const PG8_LAS bf16x8*)(lds + PG8_SB(b, h) + boff + n * 2048 + k * 1024); } while (0)
#define PG8_MMA(ai, bj, At, Bt) do { __builtin_amdgcn_s_setprio(1); _Pragma("unroll") for (int m = 0; m < 4; ++m) _Pragma("unroll") for (int n = 0; n < 2; ++n) _Pragma("unroll") for (int k = 0; k < 2; ++k) \
        acc[ai][bj][m][n] = __builtin_amdgcn_mfma_f32_16x16x32_bf16(Bt[n][k], At[m][k], acc[ai][bj][m][n], 0, 0, 0); __builtin_amdgcn_s_setprio(0); } while (0)
#define PG8_WAIT_V(n) asm volatile("s_waitcnt vmcnt(" #n ")" ::: "memory")
#define PG8_WAIT_L(n) asm volatile("s_waitcnt lgkmcnt(" #n ")" ::: "memory")
#define PG8_BAR __builtin_amdgcn_s_barrier()
#define PG8_SCHED __builtin_amdgcn_sched_barrier(0)
    Unit cur, nxt; int ui = 0;
    if (!S.next(0, cur)) return;
    f32x4 acc[2][2][4][2];
#pragma unroll
    for (int a = 0; a < 2; ++a)
#pragma unroll
        for (int b = 0; b < 2; ++b)
#pragma unroll
            for (int m = 0; m < 4; ++m)
#pragma unroll
                for (int n = 0; n < 2; ++n) acc[a][b][m][n] = (f32x4){0.f, 0.f, 0.f, 0.f};
    bf16x8 At[4][2], B0[2][2], B1[2][2];
    const char* cA = (const char*)g.A + (size_t)cur.pm * tstepA; const char* cB = (const char*)g.Bt + (size_t)cur.pn * tstep;
    S.a_ready(cur);
    if constexpr (SP2) {
        PG8_STAGE(PG8_SB(0, 0), cB, voffB); PG8_STAGE(PG8_SB(0, 1), cB + hstep, voffB); PG8_STAGE(PG8_SA(0, 0), cA, voffA); PG8_STAGE(PG8_SA(0, 1), cA + hstepA, voffA);
        if (wr == 1) PG8_BAR;
        PG8_WAIT_V(2); PG8_BAR;
        PG8_STAGE(PG8_SB(1, 0), cB + kstep, voffB); PG8_STAGE(PG8_SA(1, 0), cA + kstep, voffA); PG8_STAGE(PG8_SB(1, 1), cB + hstep + kstep, voffB);
        PG8_WAIT_V(6); PG8_BAR;
    } else {
        PG8_STAGE(PG8_SB(0, 0), cB, voffB); PG8_STAGE(PG8_SA(0, 0), cA, voffA); PG8_STAGE(PG8_SB(0, 1), cB + hstep, voffB); PG8_STAGE(PG8_SA(0, 1), cA + hstepA, voffA);
        if (wr == 1) PG8_BAR;
        PG8_WAIT_V(4); PG8_BAR;
        PG8_STAGE(PG8_SB(1, 0), cB + kstep, voffB); PG8_STAGE(PG8_SA(1, 0), cA + kstep, voffA); PG8_STAGE(PG8_SB(1, 1), cB + hstep + kstep, voffB);
        PG8_WAIT_V(6); PG8_BAR;
    }
    for (;;) {
        const bool has_next = S.next(ui + 1, nxt);
        const char* nA = has_next ? (const char*)g.A + (size_t)nxt.pm * tstepA : cA; const char* nB = has_next ? (const char*)g.Bt + (size_t)nxt.pn * tstep : cB;
        for (int t = 0; t < nt; t += 2) {
            const bool last = (t == nt - 2);
            const char* a1 = cA + (size_t)(t + 1) * kstep;
            const char* a2 = last ? nA : cA + (size_t)(t + 2) * kstep; const char* b2 = last ? nB : cB + (size_t)(t + 2) * kstep;
            const char* a3 = a2 + kstep; const char* b3 = b2 + kstep;
            if (last && has_next) S.a_ready(nxt);
            if constexpr (SP2) {
            PG8_LDB(B0, 0, 0); PG8_LDB(B1, 0, 1); PG8_SCHED; PG8_LDA(At, 0, 0); PG8_STAGE(PG8_SA(1, 1), a1 + hstepA, voffA);
            PG8_WAIT_V(8); PG8_WAIT_L(0); PG8_BAR; PG8_MMA(0, 0, At, B0); PG8_MMA(0, 1, At, B1); PG8_BAR; PG8_SCHED;
            PG8_LDA(At, 0, 1); PG8_STAGE(PG8_SB(0, 0), b2, voffB); PG8_STAGE(PG8_SB(0, 1), b2 + hstep, voffB); PG8_STAGE(PG8_SA(0, 0), a2, voffA);
            PG8_WAIT_V(8); PG8_WAIT_L(0); PG8_BAR; PG8_MMA(1, 0, At, B0); PG8_MMA(1, 1, At, B1); PG8_BAR; PG8_SCHED;
            PG8_LDB(B0, 1, 0); PG8_LDB(B1, 1, 1); PG8_SCHED; PG8_LDA(At, 1, 0); PG8_STAGE(PG8_SA(0, 1), a2 + hstepA, voffA);
            PG8_WAIT_V(8); PG8_WAIT_L(0); PG8_BAR; PG8_MMA(0, 0, At, B0); PG8_MMA(0, 1, At, B1); PG8_BAR; PG8_SCHED;
            PG8_LDA(At, 1, 1); PG8_STAGE(PG8_SB(1, 0), b3, voffB); PG8_STAGE(PG8_SB(1, 1), b3 + hstep, voffB); PG8_STAGE(PG8_SA(1, 0), a3, voffA);
            PG8_WAIT_V(8); PG8_WAIT_L(0); PG8_BAR; PG8_MMA(1, 0, At, B0); PG8_MMA(1, 1, At, B1); PG8_BAR; PG8_SCHED;
            } else {
            PG8_LDB(B0, 0, 0); PG8_SCHED; PG8_LDA(At, 0, 0); PG8_STAGE(PG8_SA(1, 1), a1 + hstepA, voffA);
            PG8_WAIT_L(8); PG8_BAR; PG8_WAIT_L(0); PG8_MMA(0, 0, At, B0); PG8_BAR; PG8_SCHED;
            PG8_LDB(B1, 0, 1); PG8_STAGE(PG8_SB(0, 0), b2, voffB);
            PG8_BAR; PG8_WAIT_L(0); PG8_MMA(0, 1, At, B1); PG8_BAR;
            PG8_LDA(At, 0, 1); PG8_STAGE(PG8_SA(0, 0), a2, voffA);
            PG8_BAR; PG8_WAIT_L(0); PG8_MMA(1, 0, At, B0); PG8_BAR; PG8_SCHED;
            PG8_STAGE(PG8_SB(0, 1), b2 + hstep, voffB);
            PG8_WAIT_V(6); PG8_BAR; PG8_MMA(1, 1, At, B1); PG8_BAR;
            PG8_LDB(B0, 1, 0); PG8_SCHED; PG8_LDA(At, 1, 0); PG8_STAGE(PG8_SA(0, 1), a2 + hstepA, voffA);
            PG8_WAIT_L(8); PG8_BAR; PG8_WAIT_L(0); PG8_MMA(0, 0, At, B0); PG8_BAR; PG8_SCHED;
            PG8_LDB(B1, 1, 1); PG8_STAGE(PG8_SB(1, 0), b3, voffB);
            PG8_BAR; PG8_WAIT_L(0); PG8_MMA(0, 1, At, B1); PG8_BAR;
            PG8_LDA(At, 1, 1); PG8_STAGE(PG8_SA(1, 0), a3, voffA);
            PG8_BAR; PG8_WAIT_L(0); PG8_MMA(1, 0, At, B0); PG8_BAR; PG8_SCHED;
            PG8_STAGE(PG8_SB(1, 1), b3 + hstep, voffB);
            PG8_WAIT_V(6); PG8_BAR; PG8_MMA(1, 1, At, B1); PG8_BAR;
            }
        }
        if constexpr (ALIGN_EPI) { if (wr == 0) PG8_BAR; }
        if constexpr (!Epi::AFTER_DRAIN) { int l2_; asm volatile("v_mbcnt_lo_u32_b32 %0, -1, 0\n\tv_mbcnt_hi_u32_b32 %0, -1, %0" : "=v"(l2_)); const int fr_ = l2_ & 15, fq_ = l2_ >> 4; E(acc, cur, wr, wc, fr_, fq_); S.done(cur); }
        if (!has_next) break;
#pragma unroll
        for (int a = 0; a < 2; ++a)
#pragma unroll
            for (int b = 0; b < 2; ++b)
#pragma unroll
                for (int m = 0; m < 4; ++m)
#pragma unroll
                    for (int n = 0; n < 2; ++n) acc[a][b][m][n] = (f32x4){0.f, 0.f, 0.f, 0.f};
        cur = nxt; cA = nA; cB = nB; ++ui;
        if constexpr (ALIGN_EPI) { if (wr == 1) PG8_BAR; }
    }
    PG8_WAIT_V(0);
    if constexpr (!ALIGN_EPI) { if (wr == 0) PG8_BAR; }
    PG8_BAR;
    if constexpr (Epi::AFTER_DRAIN) { E.fused(acc, cur, wr, wc, fr, fq, lds, wid, lane); S.done(cur); }
#undef PG8_SA
#undef PG8_SB
#undef PG8_STAGE
#undef PG8_LDA
#undef PG8_LDB
#undef PG8_MMA
#undef PG8_WAIT_V
#undef PG8_WAIT_L
#undef PG8_BAR
#undef PG8_SCHED
}
}

constexpr int M = 16384, DM = 1024, FF = 2816, SEQ = 2048, NPROJ = 5888;
constexpr float EPS = 1e-6f, LOG2E = 1.4426950408889634f;
constexpr float QSCALE = 0.125f * LOG2E;
#define LAS __attribute__((address_space(3)))
typedef unsigned short bf16;
typedef unsigned v4u __attribute__((ext_vector_type(4)));
using pg8::f32x4;

constexpr size_t MiB = 1u << 20;
constexpr size_t WS_LSE = 0;
constexpr size_t WS_SS = 251 * MiB;
constexpr size_t WS_CTR = 1 * MiB + 512 * 1024;
constexpr size_t WS_BND = 1 * MiB + 640 * 1024;
constexpr size_t WS_BAR = 1 * MiB + 768 * 1024;
constexpr size_t WS_WFI = 2 * MiB;
constexpr size_t WS_WFO = 13 * MiB;
constexpr size_t WS_WPR = 19 * MiB;
constexpr size_t WS_WA = 31 * MiB;
constexpr size_t WS_WB = 31 * MiB + 512 * 1024;
constexpr size_t WS_WO = 33 * MiB;
constexpr size_t WS_XN = 35 * MiB;
constexpr size_t WS_P = 67 * MiB;
constexpr size_t WS_QA = WS_P, WS_KA = WS_QA + 24 * MiB, WS_VA = WS_KA + 24 * MiB;
constexpr size_t WS_QD = WS_VA + 24 * MiB, WS_KD = WS_QD + 16 * MiB, WS_VD = WS_KD + 16 * MiB;
constexpr size_t WS_GA = WS_VD + 16 * MiB, WS_GB = WS_GA + 32 * MiB;
constexpr size_t WS_H = WS_P;
constexpr size_t WS_ODIL = WS_QA;
constexpr size_t WS_Y = WS_GA;
constexpr size_t WS_WFI_ALT = 156 * MiB, WS_WFO_ALT = 168 * MiB;
constexpr size_t WS_END = WS_GB + 32 * MiB;
static_assert(WS_END == 251 * MiB && WS_SS + 2 * MiB <= 256 * MiB && WS_H + (size_t)88 * MiB <= WS_WFI_ALT && WS_WFO_ALT + 6 * MiB <= WS_END, "ws map");

__device__ __forceinline__ int lane_id() { int l; asm volatile("v_mbcnt_lo_u32_b32 %0, -1, 0\n\tv_mbcnt_hi_u32_b32 %0, -1, %0" : "=v"(l)); return l; }
__device__ __forceinline__ int launder(int v) { asm volatile("" : "+v"(v)); return v; }
__device__ __forceinline__ float bf2f(unsigned short b) { return __uint_as_float(((unsigned)b) << 16); }
__device__ __forceinline__ unsigned f2bf(float f) { unsigned u = __float_as_uint(f); return (u + 0x7fffu + ((u >> 16) & 1u)) >> 16; }
__device__ __forceinline__ unsigned pk2(float lo, float hi) { return f2bf(lo) | (f2bf(hi) << 16); }
__device__ __forceinline__ float shfl_xor_f(float v, int mask) {
    int l; asm volatile("v_mbcnt_lo_u32_b32 %0, -1, 0\n\tv_mbcnt_hi_u32_b32 %0, -1, %0" : "=v"(l));
    return __int_as_float(__builtin_amdgcn_ds_bpermute((l ^ mask) << 2, __float_as_int(v)));
}
__device__ __forceinline__ float wave_sum(float v) {
#pragma unroll
    for (int o = 1; o < 64; o <<= 1) v += shfl_xor_f(v, o);
    return v;
}
__device__ __forceinline__ float wave_max(float v) {
#pragma unroll
    for (int o = 1; o < 64; o <<= 1) v = fmaxf(v, shfl_xor_f(v, o));
    return v;
}
__device__ __forceinline__ float fast_exp2(float x) { return __builtin_amdgcn_exp2f(x); }
__device__ __forceinline__ float fast_rcp(float x) { return __builtin_amdgcn_rcpf(x); }
__device__ __forceinline__ float sigmoidf_(float x) { return fast_rcp(1.0f + fast_exp2(-x * LOG2E)); }

using pg8::u32x4; using pg8::bf16_t; using pg8::Unit; using pg8::HALF; using pg8::BM; using pg8::cvt_pk_bf16;

__device__ __forceinline__ float row_rstd(const float* SS, int row) {
    const f32x4* p = (const f32x4*)(SS + (size_t)row * 16);
    const f32x4 a = p[0], b = p[1], c = p[2], d = p[3];
    const float t = (((a[0] + a[1]) + (a[2] + a[3])) + ((b[0] + b[1]) + (b[2] + b[3]))) + (((c[0] + c[1]) + (c[2] + c[3])) + ((d[0] + d[1]) + (d[2] + d[3])));
    return rsqrtf(t * (1.0f / DM) + EPS);
}
struct EpiSwiGLU {
    static constexpr bool PERM = true, AFTER_DRAIN = false;
    bf16_t* H; const float* SS;
    __device__ __forceinline__ void operator()(const f32x4 (&acc)[2][2][4][2], const Unit& u, int wr, int wc, int fr, int fq) const {
        const int row0 = u.pm * BM + wr * 64 + fr, col0 = u.pn * 128 + wc * 32 + 8 * fq;
#pragma unroll
        for (int ai = 0; ai < 2; ++ai)
#pragma unroll
            for (int m = 0; m < 4; ++m) {
                float h[8];
                const float rs = row_rstd(SS, row0 + ai * HALF + m * 16);
                const float na = -rs * LOG2E, rs2 = rs * rs;
#pragma unroll
                for (int n = 0; n < 2; ++n)
#pragma unroll
                    for (int e = 0; e < 4; e += 2) {
                        typedef float f32x2 __attribute__((ext_vector_type(2)));
                        const f32x2 g = (f32x2){acc[ai][0][m][n][e], acc[ai][0][m][n][e + 1]}, up = (f32x2){acc[ai][1][m][n][e], acc[ai][1][m][n][e + 1]};
                        const f32x2 t = g * na; f32x2 ex; ex.x = fast_exp2(t.x); ex.y = fast_exp2(t.y);
                        const f32x2 d = ex + 1.0f; f32x2 r; r.x = fast_rcp(d.x); r.y = fast_rcp(d.y);
                        const f32x2 hv = (g * up) * rs2 * r;
                        h[n * 4 + e] = hv.x; h[n * 4 + e + 1] = hv.y;
                    }
                u32x4 w; w.x = cvt_pk_bf16(h[0], h[1]); w.y = cvt_pk_bf16(h[2], h[3]); w.z = cvt_pk_bf16(h[4], h[5]); w.w = cvt_pk_bf16(h[6], h[7]);
                *(u32x4*)(H + (size_t)(row0 + ai * HALF + m * 16) * FF + col0) = w;
            }
    }
};
struct EpiResid {
    static constexpr bool PERM = true, AFTER_DRAIN = false;
    float* xout; bf16_t* XB; float* SSn; float s; int last;
    __device__ __forceinline__ void operator()(const f32x4 (&acc)[2][2][4][2], const Unit& u, int wr, int wc, int fr, int fq) const {
        const int row0 = u.pm * BM + wr * 64 + fr, col0 = u.pn * BM + wc * 32 + 8 * fq;
#pragma unroll
        for (int ai = 0; ai < 2; ++ai)
#pragma unroll
            for (int m = 0; m < 4; ++m) {
                float ss = 0.f;
#pragma unroll
                for (int bj = 0; bj < 2; ++bj) {
                    const size_t off = (size_t)(row0 + ai * HALF + m * 16) * DM + col0 + bj * HALF;
                    const u32x4 xw = *(const u32x4*)(XB + off);
                    f32x4 y0, y1;
                    y0[0] = __uint_as_float(xw.x << 16); y0[1] = __uint_as_float(xw.x & 0xffff0000u); y0[2] = __uint_as_float(xw.y << 16); y0[3] = __uint_as_float(xw.y & 0xffff0000u);
                    y1[0] = __uint_as_float(xw.z << 16); y1[1] = __uint_as_float(xw.z & 0xffff0000u); y1[2] = __uint_as_float(xw.w << 16); y1[3] = __uint_as_float(xw.w & 0xffff0000u);
                    y0 = y0 + acc[ai][bj][m][0] * s; y1 = y1 + acc[ai][bj][m][1] * s;
                    if (last) { *(f32x4*)(xout + off) = y0; *(f32x4*)(xout + off + 4) = y1; }
                    else {
                        u32x4 w; w.x = cvt_pk_bf16(y0[0], y0[1]); w.y = cvt_pk_bf16(y0[2], y0[3]); w.z = cvt_pk_bf16(y1[0], y1[1]); w.w = cvt_pk_bf16(y1[2], y1[3]);
                        *(u32x4*)(XB + off) = w;
                        ss += (y0[0] * y0[0] + y0[1] * y0[1]) + (y0[2] * y0[2] + y0[3] * y0[3]) + (y1[0] * y1[0] + y1[1] * y1[1]) + (y1[2] * y1[2] + y1[3] * y1[3]);
                    }
                }
                if (!last) { ss += shfl_xor_f(ss, 16); ss += shfl_xor_f(ss, 32); if (fq == 0) SSn[(size_t)(row0 + ai * HALF + m * 16) * 16 + u.pn * 4 + wc] = ss; }
            }
    }
};
struct EpiProj {
    static constexpr bool PERM = true, AFTER_DRAIN = false;
    unsigned char* ws; const float* gdil; const float* gdiff; const float* SS;
    __device__ __forceinline__ void operator()(const f32x4 (&acc)[2][2][4][2], const Unit& u, int wr, int wc, int fr, int fq) const {
        const int pn = u.pn;
        bf16_t* dst; int ld, ct, mode; const float* gain = nullptr; float sc = 1.f;
        if (pn < 3)       { dst = (bf16_t*)(ws + WS_QA); ld = 768;  ct = pn;      mode = 1; gain = gdil;        sc = QSCALE; }
        else if (pn < 6)  { dst = (bf16_t*)(ws + WS_KA); ld = 768;  ct = pn - 3;  mode = 1; gain = gdil + 768; }
        else if (pn < 9)  { dst = (bf16_t*)(ws + WS_VA); ld = 768;  ct = pn - 6;  mode = 0; }
        else if (pn < 11) { dst = (bf16_t*)(ws + WS_QD); ld = 512;  ct = pn - 9;  mode = 1; gain = gdiff;       sc = QSCALE; }
        else if (pn < 13) { dst = (bf16_t*)(ws + WS_KD); ld = 512;  ct = pn - 11; mode = 1; gain = gdiff + 512; }
        else if (pn < 15) { dst = (bf16_t*)(ws + WS_VD); ld = 512;  ct = pn - 13; mode = 0; }
        else if (pn < 19) { dst = (bf16_t*)(ws + WS_GA); ld = 1024; ct = pn - 15; mode = 2; }
        else              { dst = (bf16_t*)(ws + WS_GB); ld = 1024; ct = pn - 19; mode = 2; }
        const int colw = ct * 256 + wc * 64 + 8 * fq;
        const int row0 = u.pm * BM + wr * 64 + fr;
        f32x4 gv[2][2];
#pragma unroll
        for (int bj = 0; bj < 2; ++bj)
#pragma unroll
            for (int n = 0; n < 2; ++n) gv[bj][n] = (mode == 1) ? *(const f32x4*)(gain + colw + 32 * bj + 4 * n) * sc : (f32x4){1.f, 1.f, 1.f, 1.f};
#pragma unroll
        for (int ai = 0; ai < 2; ++ai)
#pragma unroll
            for (int m = 0; m < 4; ++m) {
                f32x4 v[2][2];
                const float rs = row_rstd(SS, row0 + ai * HALF + m * 16);
#pragma unroll
                for (int bj = 0; bj < 2; ++bj)
#pragma unroll
                    for (int n = 0; n < 2; ++n) v[bj][n] = acc[ai][bj][m][n] * rs;
                if (mode == 1) {
                    float ss = 0.f;
#pragma unroll
                    for (int bj = 0; bj < 2; ++bj)
#pragma unroll
                        for (int n = 0; n < 2; ++n) { const f32x4 x = v[bj][n]; ss += (x[0] * x[0] + x[1] * x[1]) + (x[2] * x[2] + x[3] * x[3]); }
                    ss += shfl_xor_f(ss, 16); ss += shfl_xor_f(ss, 32);
                    const float r = rsqrtf(ss * (1.0f / 64.0f) + EPS);
#pragma unroll
                    for (int bj = 0; bj < 2; ++bj)
#pragma unroll
                        for (int n = 0; n < 2; ++n) v[bj][n] = v[bj][n] * r * gv[bj][n];
                } else if (mode == 2) {
                    const float na = -rs * LOG2E;
#pragma unroll
                    for (int bj = 0; bj < 2; ++bj)
#pragma unroll
                        for (int n = 0; n < 2; ++n) {
                            const f32x4 t = acc[ai][bj][m][n] * na; f32x4 ex;
#pragma unroll
                            for (int e = 0; e < 4; ++e) ex[e] = fast_exp2(t[e]);
                            const f32x4 d = ex + 1.0f;
#pragma unroll
                            for (int e = 0; e < 4; ++e) v[bj][n][e] = fast_rcp(d[e]);
                        }
                }
                bf16_t* rowp = dst + (size_t)(row0 + ai * HALF + m * 16) * ld + colw;
#pragma unroll
                for (int bj = 0; bj < 2; ++bj) {
                    u32x4 w; w.x = cvt_pk_bf16(v[bj][0][0], v[bj][0][1]); w.y = cvt_pk_bf16(v[bj][0][2], v[bj][0][3]); w.z = cvt_pk_bf16(v[bj][1][0], v[bj][1][1]); w.w = cvt_pk_bf16(v[bj][1][2], v[bj][1][3]);
                    __builtin_nontemporal_store(w, (u32x4*)(rowp + 32 * bj));
                }
            }
    }
};
template <int PASS> struct EpiMerge {
    static constexpr bool PERM = true, AFTER_DRAIN = false;
    bf16_t* Y; const bf16_t* gate;
    __device__ __forceinline__ void operator()(const f32x4 (&acc)[2][2][4][2], const Unit& u, int wr, int wc, int fr, int fq) const {
        const int row0 = u.pm * BM + wr * 64 + fr, col0 = u.pn * BM + wc * 32 + 8 * fq;
#pragma unroll
        for (int ai = 0; ai < 2; ++ai)
#pragma unroll
            for (int m = 0; m < 4; ++m)
#pragma unroll
                for (int bj = 0; bj < 2; ++bj) {
                    const size_t off = (size_t)(row0 + ai * HALF + m * 16) * DM + col0 + bj * HALF;
                    const u32x4 gw = *(const u32x4*)(gate + off);
                    float y[8];
#pragma unroll
                    for (int n = 0; n < 2; ++n)
#pragma unroll
                        for (int e = 0; e < 4; ++e) {
                            const unsigned word = gw[n * 2 + (e >> 1)]; const float g = __uint_as_float((e & 1) ? (word & 0xffff0000u) : (word << 16));
                            y[n * 4 + e] = g * acc[ai][bj][m][n][e];
                        }
                    if (PASS == 2) {
                        const u32x4 yw = *(const u32x4*)(Y + off);
#pragma unroll
                        for (int i = 0; i < 8; ++i) { const unsigned word = yw[i >> 1]; y[i] += __uint_as_float((i & 1) ? (word & 0xffff0000u) : (word << 16)); }
                    }
                    u32x4 w; w.x = cvt_pk_bf16(y[0], y[1]); w.y = cvt_pk_bf16(y[2], y[3]); w.z = cvt_pk_bf16(y[4], y[5]); w.w = cvt_pk_bf16(y[6], y[7]);
                    *(u32x4*)(Y + off) = w;
                }
    }
};

template <int MODE> __device__ __forceinline__ int colmap(int n0) {
    if (MODE == 0) return n0;
    const int pn = n0 >> 8, r = n0 & 255, bj = r >> 7, wc = (r & 127) >> 5;
    if (MODE == 1) return bj * FF + 128 * pn + 32 * wc;
    return 256 * pn + 64 * wc + 32 * bj;
}
template <int MODE> __device__ __forceinline__ void convert_item(const float* W, const float* g, int K, int Nsrc, int Nphys, bf16* WT, LAS float* scr, int item, int lane) {
    const int nblk = Nphys / 32;
    const int kb = item / nblk, nb = item % nblk, k0 = 64 * kb, n0 = 32 * nb, s0 = colmap<MODE>(n0);
    {
        const int kr = lane >> 3, c4 = lane & 7;
        const float* src = W + (size_t)(k0 + kr) * Nsrc + s0 + 4 * c4;
        f32x4 v[8];
#pragma unroll
        for (int i = 0; i < 8; ++i) v[i] = __builtin_nontemporal_load((const f32x4*)(src + (size_t)(8 * i) * Nsrc));
        if (g) {
#pragma unroll
            for (int i = 0; i < 8; ++i) v[i] = v[i] * g[k0 + 8 * i + kr];
        }
#pragma unroll
        for (int i = 0; i < 8; ++i) { LAS float* d = scr + (8 * i + kr) * 33 + 4 * c4; d[0] = v[i][0]; d[1] = v[i][1]; d[2] = v[i][2]; d[3] = v[i][3]; }
    }
    asm volatile("s_waitcnt lgkmcnt(0)" ::: "memory");
    const int c = lane & 7;
#pragma unroll
    for (int j = 0; j < 4; ++j) { const int n = (lane >> 3) + 8 * j; const LAS float* s = scr + (8 * c) * 33 + n;
        v4u o; o.x = pk2(s[0 * 33], s[1 * 33]); o.y = pk2(s[2 * 33], s[3 * 33]); o.z = pk2(s[4 * 33], s[5 * 33]); o.w = pk2(s[6 * 33], s[7 * 33]);
        *(v4u*)(WT + (size_t)(n0 + n) * K + k0 + 8 * c) = o; }
    asm volatile("s_waitcnt lgkmcnt(0)" ::: "memory");
}
template <int MODE> __device__ __forceinline__ void convert_weight(const float* W, const float* g, int K, int Nsrc, int Nphys, bf16* WT, LAS float* scr, int gw, int NGW, int lane_in) {
    const int lane = launder(lane_in);
    const int nitems = (K / 64) * (Nphys / 32);
    for (int item = gw; item < nitems; item += NGW) convert_item<MODE>(W, g, K, Nsrc, Nphys, WT, scr, item, lane);
}
__device__ __forceinline__ int grab_item(unsigned* ctr, int lane) {
    unsigned v = 0; if (lane == 0) v = atomicAdd(ctr, 1u);
    return __builtin_amdgcn_readfirstlane((int)v);
}
__device__ __forceinline__ void ffn_jobs(unsigned* ctr, const float* wi, const float* g, const float* wo, bf16* WFIu, bf16* WFOu, LAS float* scr, int lane_in) {
    const int lane = launder(lane_in);
    constexpr int N0 = (DM / 64) * (2 * FF / 32), N1 = (FF / 64) * (DM / 32);
    for (;;) { const int it = grab_item(ctr, lane); if (it >= N0 + N1) break;
        if (it < N0) convert_item<1>(wi, g, DM, 2 * FF, 2 * FF, WFIu, scr, it, lane); else convert_item<0>(wo, nullptr, FF, DM, DM, WFOu, scr, it - N0, lane); }
}
__device__ __forceinline__ void mixer_jobs(unsigned* ctr, const float* win, const float* g, const float* wa, const float* wb, const float* wo, unsigned char* ws, LAS float* scr, int lane_in) {
    const int lane = launder(lane_in);
    constexpr int N0 = (DM / 64) * (NPROJ / 32), N1 = (256 / 64) * (DM / 32), N2 = (512 / 64) * (DM / 32), N3 = (DM / 64) * (DM / 32);
    for (;;) { int it = grab_item(ctr, lane); if (it >= N0 + N1 + N2 + N3) break;
        if (it < N0) { convert_item<2>(win, g, DM, NPROJ, NPROJ, (bf16*)(ws + WS_WPR), scr, it, lane); continue; } it -= N0;
        if (it < N1) { convert_item<0>(wa, nullptr, 256, DM, DM, (bf16*)(ws + WS_WA), scr, it, lane); continue; } it -= N1;
        if (it < N2) { convert_item<0>(wb, nullptr, 512, DM, DM, (bf16*)(ws + WS_WB), scr, it, lane); continue; } it -= N2;
        convert_item<0>(wo, nullptr, DM, DM, DM, (bf16*)(ws + WS_WO), scr, it, lane); }
}
__device__ __forceinline__ void prologue_rows(const float* x, bf16* XB, float* SS0, int gw, int NGW, int lane_in) {
    const int lane = launder(lane_in);
    for (int m0 = gw; m0 < M; m0 += 4 * NGW) {
        f32x4 v[4][4];
#pragma unroll
        for (int q = 0; q < 4; ++q) { const int m = m0 + q * NGW; if (m < M) { const f32x4* xr = (const f32x4*)(x + (size_t)m * DM) + lane;
#pragma unroll
            for (int j = 0; j < 4; ++j) v[q][j] = __builtin_nontemporal_load(xr + 64 * j); } }
#pragma unroll
        for (int q = 0; q < 4; ++q) { const int m = m0 + q * NGW; if (m < M) {
            float s = 0.f;
#pragma unroll
            for (int j = 0; j < 4; ++j) s += (v[q][j].x * v[q][j].x + v[q][j].y * v[q][j].y) + (v[q][j].z * v[q][j].z + v[q][j].w * v[q][j].w);
            s = wave_sum(s);
            unsigned long long* o8 = (unsigned long long*)(XB + (size_t)m * DM) + lane;
#pragma unroll
            for (int j = 0; j < 4; ++j) o8[64 * j] = (unsigned long long)pk2(v[q][j].x, v[q][j].y) | ((unsigned long long)pk2(v[q][j].z, v[q][j].w) << 32);
            if (lane < 16) SS0[(size_t)m * 16 + lane] = (lane == 0) ? s : 0.f; } }
    }
}
namespace att {
typedef short bf16x8 __attribute__((ext_vector_type(8)));
typedef short s16x4 __attribute__((ext_vector_type(4)));
typedef float f32x16 __attribute__((ext_vector_type(16)));
constexpr int KP = 144, VP64 = 192, VP128 = 320, STAGE = 43008, OFF_K1 = 9216, OFF_V = 18432, V1STEP = 12288;
struct UnitP {
    const bf16* Q; const bf16* K; const bf16* V; bf16* O;
    int pitch, scol;
    int qrow0, krow0, rs;
    int t0, t1;
    int D0, maxdist;
    float c0, c1;
    float lam, onem; const float* sub;
    float* lse; int lsecol;
    float bnd0, bnd1;
};
__device__ __forceinline__ s16x4 vtr(const LAS unsigned char* p) {
    typedef short v4i16_t __attribute__((ext_vector_type(4)));
    return __builtin_bit_cast(s16x4, __builtin_amdgcn_ds_read_tr16_b64_v4i16((LAS v4i16_t*)p));
}
__device__ __forceinline__ unsigned cvtpk(float lo, float hi) { unsigned r; asm volatile("v_cvt_pk_bf16_f32 %0, %1, %2" : "=v"(r) : "v"(lo), "v"(hi)); return r; }
__device__ __forceinline__ bf16x8 pack8(float a, float b, float c, float d, float e, float f, float g, float h) {
    v4u w; w.x = cvtpk(a, b); w.y = cvtpk(c, d); w.z = cvtpk(e, f); w.w = cvtpk(g, h); return __builtin_bit_cast(bf16x8, w);
}
template <bool DIFF, bool FAST>
__device__ __forceinline__ void attn_unit(LAS unsigned char* lds, const UnitP& P, const int wave, const int lane_in) {
    const int lane = launder(lane_in);
    constexpr int NDB = DIFF ? 4 : 2, VP = DIFF ? VP128 : VP64;
    const int sidx = wave >> 2, w4 = wave & 3, r32 = lane & 31, hi = lane >> 5, tid = wave * 64 + lane;
    const int qidx = 32 * w4 + r32;
    bf16x8 qf[4];
    { const bf16* qp = P.Q + (size_t)(P.qrow0 + qidx * P.rs) * P.pitch + sidx * P.scol + hi * 8;
#pragma unroll
      for (int ks = 0; ks < 4; ++ks) qf[ks] = *(const bf16x8*)(qp + ks * 16); }
    const size_t tstep = (size_t)64 * P.rs * P.pitch;
    const bf16* kg; const bf16* vg; int kl, vl;
    { const int ss = tid >> 8, u = tid & 255, kk = u >> 2, cp = u & 3;
      kg = P.K + ss * P.scol + cp * 16 + (long long)(P.krow0 + kk * P.rs) * P.pitch; kl = ss * OFF_K1 + kk * KP + cp * 32;
      if (DIFF) { const int kkv = tid >> 3, cpv = tid & 7; vg = P.V + cpv * 16 + (long long)(P.krow0 + kkv * P.rs) * P.pitch; vl = OFF_V + kkv * VP128 + cpv * 32; }
      else { vg = P.V + ss * P.scol + cp * 16 + (long long)(P.krow0 + kk * P.rs) * P.pitch; vl = OFF_V + ss * V1STEP + kk * VP64 + cp * 32; } }
    v4u rk0, rk1, rv0, rv1;
#define ATT_LOADT(t) do { const bf16* a_ = kg + (size_t)(t) * tstep; rk0 = *(const v4u*)a_; rk1 = *(const v4u*)(a_ + 8); const bf16* b_ = vg + (size_t)(t) * tstep; rv0 = *(const v4u*)b_; rv1 = *(const v4u*)(b_ + 8); } while (0)
#define ATT_STORET(st) do { LAS unsigned char* base_ = lds + (st) * STAGE; *(LAS v4u*)(base_ + kl) = rk0; *(LAS v4u*)(base_ + kl + 16) = rk1; *(LAS v4u*)(base_ + vl) = rv0; *(LAS v4u*)(base_ + vl + 16) = rv1; } while (0)
    float m_run = -INFINITY, l_run = 0.f;
    f32x16 o[NDB];
#pragma unroll
    for (int db = 0; db < NDB; ++db)
#pragma unroll
        for (int r = 0; r < 16; ++r) o[db][r] = 0.f;
    const float c = sidx ? P.c1 : P.c0;
    const float maxdf = (float)P.maxdist;
    const float bnd = sidx ? P.bnd1 : P.bnd0;
    f32x16 pat0, pat1;
    if (FAST) {
#pragma unroll
        for (int r = 0; r < 16; ++r) { pat0[r] = c * (float)((r & 3) + 8 * (r >> 2)); pat1[r] = pat0[r] + 32.f * c; }
    }
    ATT_LOADT(P.t0); ATT_STORET(0); __syncthreads();
    int stg = 0;
    for (int t = P.t0; t < P.t1; ++t) {
        const bool more = (t + 1 < P.t1);
        if (more) ATT_LOADT(t + 1);
        const int dbw = P.D0 - 64 * t + 32 * w4;
        if (dbw + 31 >= 0 && dbw - 63 <= P.maxdist) {
            const LAS unsigned char* Kt = lds + stg * STAGE + sidx * OFF_K1;
            const LAS unsigned char* Vt = lds + stg * STAGE + OFF_V + (DIFF ? 0 : sidx * V1STEP);
            f32x16 p0, p1;
            const LAS unsigned char* ka = Kt + r32 * KP + hi * 16;
            const float dl = (float)(dbw + r32 - 4 * hi);
            if (FAST) {
#pragma unroll
                for (int ks = 0; ks < 4; ++ks) {
                    const bf16x8 k0 = *(const LAS bf16x8*)(ka + ks * 32), k1 = *(const LAS bf16x8*)(ka + 32 * KP + ks * 32);
                    p0 = __builtin_amdgcn_mfma_f32_32x32x16_bf16(k0, qf[ks], ks == 0 ? pat0 : p0, 0, 0, 0);
                    p1 = __builtin_amdgcn_mfma_f32_32x32x16_bf16(k1, qf[ks], ks == 0 ? pat1 : p1, 0, 0, 0);
                }
                const float mm = bnd + c * dl;
                float ls = 0.f;
                if (dbw - 63 >= 0 && dbw + 31 <= P.maxdist) {
#pragma unroll
                    for (int r = 0; r < 16; ++r) { p0[r] = fast_exp2(p0[r] - mm); p1[r] = fast_exp2(p1[r] - mm); ls += p0[r] + p1[r]; }
                } else {
#pragma unroll
                    for (int r = 0; r < 16; ++r) {
                        const float d0 = dl - (float)((r & 3) + 8 * (r >> 2)), d1 = d0 - 32.f;
                        const float e0 = fast_exp2(p0[r] - mm), e1 = fast_exp2(p1[r] - mm);
                        p0[r] = (d0 >= 0.f && d0 <= maxdf) ? e0 : 0.f; p1[r] = (d1 >= 0.f && d1 <= maxdf) ? e1 : 0.f; ls += p0[r] + p1[r];
                    }
                }
                l_run += ls;
            } else {
#pragma unroll
            for (int r = 0; r < 16; ++r) { p0[r] = 0.f; p1[r] = 0.f; }
#pragma unroll
            for (int ks = 0; ks < 4; ++ks) {
                const bf16x8 k0 = *(const LAS bf16x8*)(ka + ks * 32), k1 = *(const LAS bf16x8*)(ka + 32 * KP + ks * 32);
                p0 = __builtin_amdgcn_mfma_f32_32x32x16_bf16(k0, qf[ks], p0, 0, 0, 0);
                p1 = __builtin_amdgcn_mfma_f32_32x32x16_bf16(k1, qf[ks], p1, 0, 0, 0);
            }
            float mt = -INFINITY;
#pragma unroll
            for (int r = 0; r < 16; ++r) {
                const float d0 = dl - (float)((r & 3) + 8 * (r >> 2)), d1 = d0 - 32.f;
                float s0 = fmaf(-c, d0, p0[r]), s1 = fmaf(-c, d1, p1[r]);
                s0 = (d0 >= 0.f && d0 <= maxdf) ? s0 : -INFINITY; s1 = (d1 >= 0.f && d1 <= maxdf) ? s1 : -INFINITY;
                p0[r] = s0; p1[r] = s1; mt = fmaxf(mt, fmaxf(s0, s1));
            }
            mt = fmaxf(mt, shfl_xor_f(mt, 32));
            const float m_new = fmaxf(m_run, mt), m_use = (m_new == -INFINITY) ? 0.f : m_new;
            const float alpha = fast_exp2(m_run - m_use);
            m_run = m_new;
            float ls = 0.f;
#pragma unroll
            for (int r = 0; r < 16; ++r) { p0[r] = fast_exp2(p0[r] - m_use); p1[r] = fast_exp2(p1[r] - m_use); ls += p0[r] + p1[r]; }
            l_run = l_run * alpha + ls;
            if (!__all(alpha == 1.f)) {
#pragma unroll
                for (int db = 0; db < NDB; ++db)
#pragma unroll
                    for (int r = 0; r < 16; ++r) o[db][r] *= alpha;
            }
            }
            bf16x8 pk[4];
            pk[0] = pack8(p0[0], p0[1], p0[2], p0[3], p0[4], p0[5], p0[6], p0[7]); pk[1] = pack8(p0[8], p0[9], p0[10], p0[11], p0[12], p0[13], p0[14], p0[15]);
            pk[2] = pack8(p1[0], p1[1], p1[2], p1[3], p1[4], p1[5], p1[6], p1[7]); pk[3] = pack8(p1[8], p1[9], p1[10], p1[11], p1[12], p1[13], p1[14], p1[15]);
            const LAS unsigned char* va = Vt + (4 * hi + ((lane & 15) >> 2)) * VP + (16 * ((lane >> 4) & 1) + 4 * (lane & 3)) * 2;
            s16x4 vlo[2][NDB], vhi[2][NDB];
            const unsigned vaddr = (unsigned)(size_t)va;
#define ATT_TR(dst, off) asm volatile("ds_read_b64_tr_b16 %0, %1 offset:%c2" : "=&v"(dst) : "v"(vaddr), "i"(off) : "memory")
#pragma unroll
            for (int db = 0; db < NDB; ++db) { ATT_TR(vlo[0][db], db * 64); ATT_TR(vhi[0][db], 8 * VP + db * 64); }
#pragma unroll
            for (int s = 0; s < 4; ++s) {
                if (s < 3) {
#pragma unroll
                    for (int db = 0; db < NDB; ++db) { ATT_TR(vlo[(s + 1) & 1][db], (16 * (s + 1)) * VP + db * 64); ATT_TR(vhi[(s + 1) & 1][db], (16 * (s + 1) + 8) * VP + db * 64); }
                    if (NDB == 4) asm volatile("s_waitcnt lgkmcnt(8)" ::: "memory"); else asm volatile("s_waitcnt lgkmcnt(4)" ::: "memory");
                } else asm volatile("s_waitcnt lgkmcnt(0)" ::: "memory");
                __builtin_amdgcn_sched_barrier(0);
                __builtin_amdgcn_s_setprio(1);
#pragma unroll
                for (int db = 0; db < NDB; ++db) {
                    s16x4 lo = vlo[s & 1][db], hh = vhi[s & 1][db];
                    asm volatile("" : "+v"(lo), "+v"(hh));
                    const bf16x8 vf = (bf16x8){lo[0], lo[1], lo[2], lo[3], hh[0], hh[1], hh[2], hh[3]};
                    o[db] = __builtin_amdgcn_mfma_f32_32x32x16_bf16(vf, pk[s], o[db], 0, 0, 0);
                }
                __builtin_amdgcn_s_setprio(0);
                __builtin_amdgcn_sched_barrier(0);
            }
#undef ATT_TR
        }
        if (more) ATT_STORET(stg ^ 1);
        __syncthreads();
        stg ^= 1;
    }
#undef ATT_LOADT
#undef ATT_STORET
    const float l_tot = l_run + shfl_xor_f(l_run, 32);
    const float inv = 1.f / l_tot;
    if (!DIFF) {
        bf16* op = P.O + (size_t)(P.qrow0 + qidx * P.rs) * P.pitch + sidx * P.scol + 4 * hi;
#pragma unroll
        for (int db = 0; db < NDB; ++db)
#pragma unroll
            for (int rq = 0; rq < 4; ++rq) {
                const unsigned w0 = cvtpk(o[db][4 * rq] * inv, o[db][4 * rq + 1] * inv), w1 = cvtpk(o[db][4 * rq + 2] * inv, o[db][4 * rq + 3] * inv);
                *(unsigned long long*)(op + 32 * db + 8 * rq) = (unsigned long long)w0 | ((unsigned long long)w1 << 32);
            }
        if (hi == 0) P.lse[(size_t)(P.qrow0 + qidx * P.rs) * 12 + P.lsecol + sidx] = (FAST ? bnd : m_run) + log2f(l_tot);
    } else {
        LAS float* X = (LAS float*)lds;
        if (sidx == 1) {
            const float sc = P.lam * inv;
#pragma unroll
            for (int db = 0; db < NDB; ++db)
#pragma unroll
                for (int r = 0; r < 16; ++r) X[((w4 * 4 + db) * 16 + r) * 64 + lane] = o[db][r] * sc;
        }
        __syncthreads();
        if (sidx == 0) {
            float ss = 0.f;
#pragma unroll
            for (int db = 0; db < NDB; ++db)
#pragma unroll
                for (int r = 0; r < 16; ++r) { const float v = o[db][r] * inv - X[((w4 * 4 + db) * 16 + r) * 64 + lane]; o[db][r] = v; ss += v * v; }
            ss += shfl_xor_f(ss, 32);
            const float rr = rsqrtf(ss * (1.f / 128.f) + EPS) * P.onem;
            bf16* op = P.O + (size_t)(P.qrow0 + qidx) * P.pitch + 4 * hi;
            const float* gp = P.sub + 4 * hi;
#pragma unroll
            for (int db = 0; db < NDB; ++db)
#pragma unroll
                for (int rq = 0; rq < 4; ++rq) {
                    const f32x4 g = *(const f32x4*)(gp + 32 * db + 8 * rq);
                    const unsigned w0 = cvtpk(o[db][4 * rq] * rr * g[0], o[db][4 * rq + 1] * rr * g[1]), w1 = cvtpk(o[db][4 * rq + 2] * rr * g[2], o[db][4 * rq + 3] * rr * g[3]);
                    *(unsigned long long*)(op + 32 * db + 8 * rq) = (unsigned long long)w0 | ((unsigned long long)w1 << 32);
                }
        }
        __syncthreads();
    }
}
__device__ __forceinline__ float slope2(int head) { return exp2f(-0.5f * (float)(head + 1)) * LOG2E; }
__device__ __forceinline__ float qk_bound(const float* gq, const float* gk, int lane) {
    return 64.f * QSCALE * wave_max(fabsf(gq[lane])) * wave_max(fabsf(gk[lane])) * 1.02f + 0.25f;
}
__device__ __forceinline__ void diff_phase(LAS unsigned char* lds, unsigned char* ws, const float* sub, const float* bnds, float lam, float lam_init, int bx, int G, int wave, int lane, bf16* Oalt = nullptr) {
    for (int it = bx; it < 256; it += G) {
        const int b = it & 7, h = (it >> 6) & 3, p = (it >> 3) & 7;
        for (int half = 0; half < 2; ++half) {
            const int qb = half ? 15 - p : p;
            UnitP P;
            P.Q = (const bf16*)(ws + WS_QD) + h * 128; P.K = (const bf16*)(ws + WS_KD) + h * 128; P.V = (const bf16*)(ws + WS_VD) + h * 128; P.O = (Oalt ? Oalt : (bf16*)(ws + WS_QD)) + h * 128;
            P.pitch = 512; P.scol = 64; P.qrow0 = b * SEQ + qb * 128; P.krow0 = b * SEQ; P.rs = 1; P.t0 = 0; P.t1 = 2 * (qb + 1);
            P.D0 = qb * 128; P.maxdist = 1 << 20; P.c0 = P.c1 = slope2(12 + h); P.lam = lam; P.onem = 1.f - lam_init; P.sub = sub + h * 128; P.lse = nullptr; P.lsecol = 0;
            P.bnd0 = bnds[12 + 2 * h]; P.bnd1 = bnds[13 + 2 * h];
            if (P.bnd0 <= 40.f && P.bnd1 <= 40.f) attn_unit<true, true>(lds, P, wave, lane); else attn_unit<true, false>(lds, P, wave, lane);
        }
    }
}
__device__ __forceinline__ void dil_phase(LAS unsigned char* lds, unsigned char* ws, const float* bnds, int bx, int G, int wave, int lane, bf16* Oalt = nullptr) {
    for (int u = bx; u < 768; u += G) {
        int pair, g, r, n;
        const int b = u & 7, v = u >> 3;
        if (v < 54) { pair = v / 27; const int j = v % 27; if (j < 15) { g = 0; r = 0; n = j + 1; } else { g = 1; r = (j - 15) / 3; n = (j - 15) % 3 + 1; } }
        else { const int w = v - 54; pair = w / 21; const int j = w % 21; n = 0; if (j == 0) { g = 0; r = 0; } else if (j < 5) { g = 1; r = j - 1; } else { g = 2; r = j - 5; } }
        const int hg0 = pair * 2, dil = 1 << (2 * g), head = g * 4 + hg0;
        UnitP P;
        P.Q = (const bf16*)(ws + WS_QA) + head * 64; P.K = (const bf16*)(ws + WS_KA) + head * 64; P.V = (const bf16*)(ws + WS_VA) + head * 64; P.O = (Oalt ? Oalt : (bf16*)(ws + WS_QA)) + head * 64;
        P.pitch = 768; P.scol = 64; P.rs = dil; P.qrow0 = b * SEQ + r + n * 128 * dil; P.krow0 = b * SEQ + r + (n - 1) * 128 * dil;
        P.t0 = (n == 0) ? 2 : 0; P.t1 = 4; P.D0 = 128; P.maxdist = 128; P.c0 = slope2(head) * (float)dil; P.c1 = slope2(head + 1) * (float)dil;
        P.lam = 0.f; P.onem = 0.f; P.sub = nullptr; P.lse = (float*)(ws + WS_LSE); P.lsecol = head;
        P.bnd0 = bnds[head]; P.bnd1 = bnds[head + 1];
        if (P.bnd0 <= 40.f && P.bnd1 <= 40.f) attn_unit<false, true>(lds, P, wave, lane); else attn_unit<false, false>(lds, P, wave, lane);
    }
}
__device__ __forceinline__ void dil_combine(unsigned char* ws, int gw, int NGW, int lane_in) {
    const int lane = launder(lane_in);
    const bf16* OG = (const bf16*)(ws + WS_QA); const float* LSE = (const float*)(ws + WS_LSE); bf16* OD = (bf16*)(ws + WS_ODIL);
    for (int item = gw; item < M; item += NGW) {
        const int row = ((item >> 3) & 7) * SEQ + ((item >> 6) << 3) + (item & 7), hg = lane >> 4, c4 = (lane & 15) * 4;
        const float l0 = LSE[(size_t)row * 12 + hg], l1 = LSE[(size_t)row * 12 + 4 + hg], l2 = LSE[(size_t)row * 12 + 8 + hg];
        const float mx = fmaxf(l0, fmaxf(l1, l2)), e0 = exp2f(l0 - mx), e1 = exp2f(l1 - mx), e2 = exp2f(l2 - mx), is = 1.f / (e0 + e1 + e2);
        const float a0 = e0 * is, a1 = e1 * is, a2 = e2 * is;
        const unsigned long long w0 = *(const unsigned long long*)(OG + (size_t)row * 768 + hg * 64 + c4), w1 = *(const unsigned long long*)(OG + (size_t)row * 768 + 256 + hg * 64 + c4),
                                 w2 = *(const unsigned long long*)(OG + (size_t)row * 768 + 512 + hg * 64 + c4);
        float y[4];
#pragma unroll
        for (int e = 0; e < 4; ++e) y[e] = a0 * bf2f((unsigned short)(w0 >> (16 * e))) + a1 * bf2f((unsigned short)(w1 >> (16 * e))) + a2 * bf2f((unsigned short)(w2 >> (16 * e)));
        *(unsigned long long*)(OD + (size_t)row * 768 + hg * 64 + c4) = (unsigned long long)pk2(y[0], y[1]) | ((unsigned long long)pk2(y[2], y[3]) << 32);
    }
}
}

#define XB_TMO      128
#define XB_XCNT(j)  (256  + 64 * (j))
#define XB_XSUB(j)  (1280 + 64 * (j))
#define XB_XGEN(j)  (2304 + 64 * (j))
#define XB_TOP      3328
#define XB_TOPGEN   3392
#define XCD_BAR_WORDS 3456
#define XB_EXIT 3456
#define XB_SPIN_CAP (1u << 18)

__device__ __forceinline__ unsigned xb_ld(unsigned* p)              { return __hip_atomic_load(p, __ATOMIC_RELAXED, __HIP_MEMORY_SCOPE_AGENT); }
__device__ __forceinline__ unsigned xb_add(unsigned* p, unsigned v) { return __hip_atomic_fetch_add(p, v, __ATOMIC_RELAXED, __HIP_MEMORY_SCOPE_AGENT); }
__device__ __forceinline__ unsigned xb_xcc_id() { return (unsigned)__builtin_amdgcn_s_getreg((3 << 11) | 20) & 0xFu; }
#define XB_SPIN(cond, bar) do { unsigned _sp = 0; while (cond) { __builtin_amdgcn_s_sleep(1); \
    if ((++_sp & 255u) == 0u) { if (xb_ld(&(bar)[XB_TMO])) break; if (_sp > XB_SPIN_CAP) { atomicAdd(&(bar)[XB_TMO], 1u); break; } } } } while (0)

__device__ unsigned g_barwords[XCD_BAR_WORDS + 64];
struct XcdBarrier {
    unsigned* bar; unsigned x;
    volatile LAS unsigned* st;
};

__device__ __forceinline__ XcdBarrier xcd_barrier_post(unsigned* bar, volatile LAS unsigned* st, bool t0) {
    XcdBarrier b; b.bar = bar; b.x = xb_xcc_id(); b.st = st;
    if (t0) (void)xb_add(&bar[XB_XCNT(b.x)], 1u);
    return b;
}
__device__ __forceinline__ void xcd_barrier_complete(unsigned* bar, unsigned x, unsigned& nloc, unsigned& nx) {
    const unsigned G = gridDim.x * gridDim.y * gridDim.z;
    unsigned sum, cnt, mine, sp = 0u;
    for (;;) {
        sum = 0u; cnt = 0u; mine = 0u;
#pragma unroll
        for (unsigned j = 0; j < 16; ++j) { const unsigned c = xb_ld(&bar[XB_XCNT(j)]); sum += c; cnt += (c > 0u) ? 1u : 0u; mine = (j == x) ? c : mine; }
        if (sum == G) break;
        __builtin_amdgcn_s_sleep(1);
        if ((++sp & 255u) == 0u) { if (xb_ld(&bar[XB_TMO])) break; if (sp > XB_SPIN_CAP) { atomicAdd(&bar[XB_TMO], 1u); break; } }
    }
    nloc = mine > 0u ? mine : 1u; nx = cnt > 0u ? cnt : 1u;
}

__device__ __forceinline__ void xcd_barrier(const XcdBarrier& b, bool t0) {
    asm volatile("s_waitcnt vmcnt(0)" ::: "memory");
    __syncthreads();
    if (t0) {
        unsigned* bar = b.bar;
        __builtin_amdgcn_s_waitcnt(0);
        unsigned nloc = b.st[0], nx = b.st[1];
        if (nloc == 0u) { xcd_barrier_complete(bar, b.x, nloc, nx); b.st[0] = nloc; b.st[1] = nx; }
        const unsigned old = xb_add(&bar[XB_XSUB(b.x)], 1u);
        const unsigned gen = old / nloc;
        if (old + 1u == (gen + 1u) * nloc) {
            __builtin_amdgcn_fence(__ATOMIC_RELEASE, "agent");
            asm volatile("s_waitcnt vmcnt(0)" ::: "memory");
            const unsigned og = xb_add(&bar[XB_TOP], 1u);
            const unsigned tg = og / nx;
            if (og + 1u == (tg + 1u) * nx) xb_add(&bar[XB_TOPGEN], 1u);
            else XB_SPIN(xb_ld(&bar[XB_TOPGEN]) == tg, bar);
            __builtin_amdgcn_fence(__ATOMIC_ACQUIRE, "agent");
            xb_add(&bar[XB_XGEN(b.x)], 1u);
            asm volatile("s_waitcnt vmcnt(0)" ::: "memory");
        } else {
            XB_SPIN(xb_ld(&bar[XB_XGEN(b.x)]) == gen, bar);
            __builtin_amdgcn_fence(__ATOMIC_ACQUIRE, "agent");
            asm volatile("s_waitcnt vmcnt(0)" ::: "memory");
        }
    }
    __syncthreads();
}

#define XB_FLAG 192
__device__ __forceinline__ void xcc_local_barrier(unsigned* bar, unsigned x, unsigned nloc, bool t0) {
    asm volatile("s_waitcnt vmcnt(0)" ::: "memory");
    __syncthreads();
    if (t0) {
        __builtin_amdgcn_s_waitcnt(0);
        const unsigned old = xb_add(&bar[XB_XSUB(x)], 1u), gen = old / nloc;
        if (old + 1u == (gen + 1u) * nloc) xb_add(&bar[XB_XGEN(x)], 1u);
        else XB_SPIN(xb_ld(&bar[XB_XGEN(x)]) == gen, bar);
        __builtin_amdgcn_fence(__ATOMIC_ACQUIRE, "agent");
        asm volatile("s_waitcnt vmcnt(0)" ::: "memory");
    }
    __syncthreads();
}
struct Args {
    const float* x; const float* ffn1_norm; const float* ffn1_w_in; const float* ffn1_w_out; const float* mix_norm; const float* w_in;
    const float* qk_gain_dil; const float* qk_gain_diff; const float* lambda_q; const float* lambda_k; const float* diff_subnorm;
    const float* w_branch_dil; const float* w_branch_diff; const float* w_out; const float* ffn2_norm; const float* ffn2_w_in; const float* ffn2_w_out;
    float* out; unsigned char* ws;
};
constexpr int LDS_BYTES = 147456;

__device__ __forceinline__ const float* ldptr(LAS unsigned long long* ptab, int i) {
    const unsigned long long v = ptab[i];
    const unsigned lo = __builtin_amdgcn_readfirstlane((unsigned)v), hi = __builtin_amdgcn_readfirstlane((unsigned)(v >> 32));
    return (const float*)(((unsigned long long)hi << 32) | lo);
}
constexpr int PTAB_OFF = LDS_BYTES - 256;
enum { I_X = 0, I_F1N, I_F1I, I_F1O, I_MN, I_WIN, I_GDIL, I_GDIFF, I_LQ, I_LK, I_SUB, I_WA, I_WB, I_WO, I_F2N, I_F2I, I_F2O, I_OUT, I_WS };
__global__ void __launch_bounds__(512, 2) fwd_kernel(Args a) {
    extern __shared__ __attribute__((aligned(16))) unsigned char lds_raw[];
    cg::grid_group grid = cg::this_grid();
    LAS unsigned char* lds = (LAS unsigned char*)lds_raw;
    if (threadIdx.x == 0) {
        LAS unsigned long long* ptab = (LAS unsigned long long*)(lds + PTAB_OFF);
        ptab[I_X] = (unsigned long long)a.x; ptab[I_F1N] = (unsigned long long)a.ffn1_norm; ptab[I_F1I] = (unsigned long long)a.ffn1_w_in; ptab[I_F1O] = (unsigned long long)a.ffn1_w_out;
        ptab[I_MN] = (unsigned long long)a.mix_norm; ptab[I_WIN] = (unsigned long long)a.w_in; ptab[I_GDIL] = (unsigned long long)a.qk_gain_dil; ptab[I_GDIFF] = (unsigned long long)a.qk_gain_diff;
        ptab[I_LQ] = (unsigned long long)a.lambda_q; ptab[I_LK] = (unsigned long long)a.lambda_k; ptab[I_SUB] = (unsigned long long)a.diff_subnorm; ptab[I_WA] = (unsigned long long)a.w_branch_dil;
        ptab[I_WB] = (unsigned long long)a.w_branch_diff; ptab[I_WO] = (unsigned long long)a.w_out; ptab[I_F2N] = (unsigned long long)a.ffn2_norm; ptab[I_F2I] = (unsigned long long)a.ffn2_w_in;
        ptab[I_F2O] = (unsigned long long)a.ffn2_w_out; ptab[I_OUT] = (unsigned long long)a.out; ptab[I_WS] = (unsigned long long)a.ws;
    }
    const int wave0 = __builtin_amdgcn_readfirstlane(threadIdx.x >> 6);
    if (threadIdx.x < 3) ((volatile LAS unsigned*)(lds + PTAB_OFF + 192))[threadIdx.x] = 0u;
    __syncthreads();
    if (a.ws == nullptr) grid.sync();
    (void)xcd_barrier_post(g_barwords, (volatile LAS unsigned*)(lds + PTAB_OFF + 192), threadIdx.x == 0);
    if (threadIdx.x == 0 && (xb_xcc_id() != (blockIdx.x & 7u) || gridDim.x != 256u)) (void)xb_add(g_barwords + XB_FLAG, 1u);
#define GRID_SYNC() do { XcdBarrier b_; b_.bar = g_barwords; b_.x = xb_xcc_id(); b_.st = (volatile LAS unsigned*)(lds + PTAB_OFF + 192 + launder(0)); xcd_barrier(b_, wave == 0 && lane_id() == 0); } while (0)
#define GRID_SYNC_L() do { volatile LAS unsigned* st_ = (volatile LAS unsigned*)(lds + PTAB_OFF + 192 + launder(0)); \
        if (__builtin_amdgcn_readfirstlane((int)st_[2])) { \
            xcc_local_barrier(g_barwords, xb_xcc_id(), (unsigned)__builtin_amdgcn_readfirstlane((int)st_[0]), wave == 0 && lane_id() == 0); \
        } else GRID_SYNC(); } while (0)

    {
        int wave = wave0; asm volatile("" : "+s"(wave));
        const int G = gridDim.x, bx = blockIdx.x, gw = bx * 8 + wave, NGW = G * 8;
        LAS unsigned long long* ptab = (LAS unsigned long long*)(lds + PTAB_OFF + launder(0));
        unsigned char* ws = (unsigned char*)ldptr(ptab, I_WS);
        LAS float* scr = (LAS float*)(lds + wave * 16384);
        float* SS = (float*)(ws + WS_SS);
        { const int ln = lane_id(); if (bx == 0 && wave == 0 && ln < 8) ((unsigned*)(ws + WS_CTR))[ln * 64] = 0u; }
        convert_weight<1>(ldptr(ptab, I_F1I), ldptr(ptab, I_F1N), DM, 2 * FF, 2 * FF, (bf16*)(ws + WS_WFI), scr, gw, NGW, lane_id());
        convert_weight<0>(ldptr(ptab, I_F1O), nullptr, FF, DM, DM, (bf16*)(ws + WS_WFO), scr, gw, NGW, lane_id());
        if (gw < 40) {
            const int l = gw / 20, j = gw % 20, ln = lane_id();
            const float* gq; const float* gk;
            if (j < 12) { gq = ldptr(ptab, I_GDIL) + (size_t)l * 1536 + j * 64; gk = gq + 768; }
            else { gq = ldptr(ptab, I_GDIFF) + (size_t)l * 1024 + (j - 12) * 64; gk = gq + 512; }
            const float b = att::qk_bound(gq, gk, ln);
            if (ln == 0) ((float*)(ws + WS_BND))[gw] = b;
        }
        prologue_rows(ldptr(ptab, I_X), (bf16*)(ws + WS_XN), SS, gw, NGW, lane_id());
        GRID_SYNC();
        if (wave == 0 && lane_id() == 0) ((volatile LAS unsigned*)(lds + PTAB_OFF + 192))[2] = (xb_ld(g_barwords + XB_FLAG) == 0u) ? 1u : 0u;
        __syncthreads();
    }
    for (int st = 0; st < 6; ++st) {
        const int l = st / 3, s = st % 3;
        int wave = wave0; asm volatile("" : "+s"(wave));
        const int G = gridDim.x, bx = blockIdx.x, gw = bx * 8 + wave, NGW = G * 8;
        LAS unsigned long long* ptab = (LAS unsigned long long*)(lds + PTAB_OFF + launder(0));
        unsigned char* ws = (unsigned char*)ldptr(ptab, I_WS);
        float* out = (float*)ldptr(ptab, I_OUT);
        bf16* XN = (bf16*)(ws + WS_XN); bf16* Hb = (bf16*)(ws + WS_H);
        const float* SScur = (const float*)(ws + WS_SS) + (size_t)(st & 1) * M * 16; float* SSnext = (float*)(ws + WS_SS) + (size_t)((st + 1) & 1) * M * 16;
        unsigned* ctrs = (unsigned*)(ws + WS_CTR);
        LAS float* scr = (LAS float*)(lds + wave * 16384);
        if (s != 1) {
            const bool alt = (s == 0 && l == 1);
            const bf16* WFIu = (const bf16*)(ws + (alt ? WS_WFI_ALT : WS_WFI)); const bf16* WFOu = (const bf16*)(ws + (alt ? WS_WFO_ALT : WS_WFO));
            { pg8::Gemm g{XN, WFIu, M, 2 * FF, DM}; pg8::StaticOrder S; S.init(M, 2 * FF, G, bx); EpiSwiGLU E{Hb, SScur};
              pg8::gemm_phase<EpiSwiGLU, pg8::StaticOrder, true, true>(lds, g, S, E, wave); }
            if (s == 0)
                mixer_jobs(ctrs + 64 * (l == 0 ? 0 : 3), ldptr(ptab, I_WIN) + (size_t)l * DM * NPROJ, ldptr(ptab, I_MN) + (size_t)l * DM, ldptr(ptab, I_WA) + (size_t)l * 256 * DM,
                           ldptr(ptab, I_WB) + (size_t)l * 512 * DM, ldptr(ptab, I_WO) + (size_t)l * DM * DM, ws, scr, lane_id());
            else if (l == 0)
                ffn_jobs(ctrs + 64 * 2, ldptr(ptab, I_F1I) + (size_t)DM * 2 * FF, ldptr(ptab, I_F1N) + DM, ldptr(ptab, I_F1O) + (size_t)FF * DM, (bf16*)(ws + WS_WFI_ALT), (bf16*)(ws + WS_WFO_ALT), scr, lane_id());
            GRID_SYNC_L();
            { pg8::Gemm g{Hb, WFOu, M, DM, FF}; pg8::StaticOrder S; S.init(M, DM, G, bx); EpiResid E{out, XN, SSnext, 0.5f, st == 5 ? 1 : 0};
              pg8::gemm_phase<EpiResid, pg8::StaticOrder, true, true>(lds, g, S, E, wave); }
            GRID_SYNC();
        } else {
            { pg8::Gemm g{XN, (const bf16*)(ws + WS_WPR), M, NPROJ, DM}; pg8::StaticOrder S; S.init(M, NPROJ, G, bx);
              EpiProj E{ws, ldptr(ptab, I_GDIL) + (size_t)l * 1536, ldptr(ptab, I_GDIFF) + (size_t)l * 1024, SScur};
              pg8::gemm_phase<EpiProj, pg8::StaticOrder, true, true>(lds, g, S, E, wave); }
            ffn_jobs(ctrs + 64 * (l == 0 ? 1 : 4), ldptr(ptab, I_F2I) + (size_t)l * DM * 2 * FF, ldptr(ptab, I_F2N) + (size_t)l * DM, ldptr(ptab, I_F2O) + (size_t)l * FF * DM, (bf16*)(ws + WS_WFI), (bf16*)(ws + WS_WFO), scr, lane_id());
            GRID_SYNC_L();
            {
                const float lam_init = 0.8f - 0.6f * expf(-0.3f * (float)l);
                const float* lq = ldptr(ptab, I_LQ) + l * 128; const float* lk = ldptr(ptab, I_LK) + l * 128;
                const int ln = lane_id();
                const float d0 = wave_sum(lq[ln] * lk[ln]), d1 = wave_sum(lq[64 + ln] * lk[64 + ln]);
                const float lam = expf(d0) - expf(d1) + lam_init;
                att::diff_phase(lds, ws, ldptr(ptab, I_SUB) + l * 512, (const float*)(ws + WS_BND) + l * 20, lam, lam_init, bx, G, wave, lane_id());
                att::dil_phase(lds, ws, (const float*)(ws + WS_BND) + l * 20, bx, G, wave, lane_id());
                GRID_SYNC_L();
                att::dil_combine(ws, gw, NGW, lane_id());
            }
            GRID_SYNC_L();
            {
            { pg8::Gemm g{(const bf16*)(ws + WS_ODIL), (const bf16*)(ws + WS_WA), M, DM, 256, 768}; pg8::StaticOrder S; S.init(M, DM, G, bx); EpiMerge<1> E{(bf16*)(ws + WS_Y), (const bf16*)(ws + WS_GA)};
              pg8::gemm_phase<EpiMerge<1>, pg8::StaticOrder, true, true>(lds, g, S, E, wave); }
            { pg8::Gemm g{(const bf16*)(ws + WS_QD), (const bf16*)(ws + WS_WB), M, DM, 512}; pg8::StaticOrder S; S.init(M, DM, G, bx); EpiMerge<2> E{(bf16*)(ws + WS_Y), (const bf16*)(ws + WS_GB)};
              pg8::gemm_phase<EpiMerge<2>, pg8::StaticOrder, true, true>(lds, g, S, E, wave); }
            }
            GRID_SYNC_L();
            { pg8::Gemm g{(const bf16*)(ws + WS_Y), (const bf16*)(ws + WS_WO), M, DM, DM}; pg8::StaticOrder S; S.init(M, DM, G, bx); EpiResid E{out, XN, SSnext, 1.0f, 0};
              pg8::gemm_phase<EpiResid, pg8::StaticOrder, true, true>(lds, g, S, E, wave); }
            GRID_SYNC();
        }
    }
    {
        int wave = wave0; asm volatile("" : "+s"(wave));
        volatile LAS unsigned* ex = (volatile LAS unsigned*)(lds + PTAB_OFF + 192 + launder(0));
        const unsigned ln = (unsigned)lane_id();
        if (wave == 0 && ln == 0u) ex[3] = (xb_add(&g_barwords[XB_EXIT], 1u) == gridDim.x - 1u) ? 1u : 0u;
        __syncthreads();
        if (ex[3]) for (unsigned i = (unsigned)wave * 64u + ln; i < XCD_BAR_WORDS + 64u; i += 512u) __hip_atomic_store(&g_barwords[i], 0u, __ATOMIC_RELAXED, __HIP_MEMORY_SCOPE_AGENT);
    }
}

extern "C" void kernel_launch(void* const* d_in, const int* in_sizes, int n_in, void* d_out, int out_size, void* d_ws, size_t ws_size, hipStream_t stream) {
    static int grid = 0;
    if (grid == 0) {
        if (n_in != 17 || out_size != M * DM || ws_size < WS_SS + 2 * MiB) { fprintf(stderr, "kernel_launch: unexpected shapes (n_in %d out %d ws %zu)\n", n_in, out_size, ws_size); grid = -1; return; }
        int dev = 0, cus = 0, per_cu = 0;
        hipGetDevice(&dev); hipDeviceGetAttribute(&cus, hipDeviceAttributeMultiprocessorCount, dev);
        hipFuncSetAttribute((const void*)fwd_kernel, hipFuncAttributeMaxDynamicSharedMemorySize, LDS_BYTES);
        hipOccupancyMaxActiveBlocksPerMultiprocessor(&per_cu, (const void*)fwd_kernel, 512, LDS_BYTES);
        if (per_cu < 1) { fprintf(stderr, "kernel_launch: occupancy query says %d blocks/CU\n", per_cu); per_cu = 1; }
        (void)hipGetLastError();
        grid = cus;
    }
    if (grid < 0) return;
    Args a{};
    a.x = (const float*)d_in[0]; a.ffn1_norm = (const float*)d_in[1]; a.ffn1_w_in = (const float*)d_in[2]; a.ffn1_w_out = (const float*)d_in[3];
    a.mix_norm = (const float*)d_in[4]; a.w_in = (const float*)d_in[5]; a.qk_gain_dil = (const float*)d_in[6]; a.qk_gain_diff = (const float*)d_in[7];
    a.lambda_q = (const float*)d_in[8]; a.lambda_k = (const float*)d_in[9]; a.diff_subnorm = (const float*)d_in[10]; a.w_branch_dil = (const float*)d_in[11];
    a.w_branch_diff = (const float*)d_in[12]; a.w_out = (const float*)d_in[13]; a.ffn2_norm = (const float*)d_in[14]; a.ffn2_w_in = (const float*)d_in[15]; a.ffn2_w_out = (const float*)d_in[16];
    a.out = (float*)d_out; a.ws = (unsigned char*)d_ws;
    void* args[] = {&a};
    hipError_t e = hipLaunchCooperativeKernel((const void*)fwd_kernel, dim3(grid), dim3(512), args, LDS_BYTES, stream);
    if (e != hipSuccess) fprintf(stderr, "kernel_launch: cooperative launch failed: %s (grid %d)\n", hipGetErrorString(e), grid);
}
```
